# Optimizing an MI355X kernel written in HIP

```python
import math
import jax, jax.numpy as jnp
from jax import lax
import numpy as np

D_MODEL = 1024
BATCH = 4
SEQ = 4096
DEPTH = 4

HEAD_DIM = 128
N_MIX_HEADS = D_MODEL // HEAD_DIM
N_DN_HEADS = N_MIX_HEADS // 2
N_FOX_HEADS = N_MIX_HEADS - N_DN_HEADS
N_SB_HEADS = N_MIX_HEADS
D_DN = N_DN_HEADS * HEAD_DIM
D_FOX = N_FOX_HEADS * HEAD_DIM
CONV_WIDTH = 4
CHUNK = 64
Q_BLOCK = 128
D_FF = 2816
N_EVEN = (DEPTH + 1) // 2
N_ODD = DEPTH // 2
EPS = 1e-6
EVEN_SPLITS = (3 * D_DN, D_DN, N_DN_HEADS, N_DN_HEADS, D_FOX, D_FOX, D_FOX, D_FOX, N_FOX_HEADS)
D_IN_EVEN = 3 * D_DN + D_DN + 2 * N_DN_HEADS + 4 * D_FOX + N_FOX_HEADS
D_IN_ODD = 3 * N_SB_HEADS * HEAD_DIM

kernel_name = 'hybrid_deltanet_fox_stickbreak_macaron'


def _split(t, sizes):
    out, off = [], 0
    for s in sizes:
        out.append(t[..., off:off + s])
        off += s
    return out


def rmsnorm(x, g):
    xf = x.astype(jnp.float32)
    y = xf * lax.rsqrt(jnp.mean(xf * xf, axis=-1, keepdims=True) + EPS)
    return (y * g.astype(jnp.float32)).astype(x.dtype)


def l2norm(t):
    tf = t.astype(jnp.float32)
    return tf * lax.rsqrt(jnp.sum(tf * tf, axis=-1, keepdims=True) + EPS)


def swiglu_ffn(x, w_gu, w_down):
    g, u = jnp.split(x @ w_gu, 2, axis=-1)
    return (jax.nn.silu(g) * u) @ w_down


def split_heads(t, n):
    b, s, _ = t.shape
    return t.reshape(b, s, n, -1).transpose(0, 2, 1, 3)


def merge_heads(t):
    b, n, s, d = t.shape
    return t.transpose(0, 2, 1, 3).reshape(b, s, n * d)


def causal_conv_silu(x, w):
    s = x.shape[1]
    xp = jnp.pad(x, ((0, 0), (CONV_WIDTH - 1, 0), (0, 0)))
    y = sum(xp[:, i:i + s, :] * w[i] for i in range(CONV_WIDTH))
    return jax.nn.silu(y)


def gated_delta_rule(q, k, v, beta, g):
    b, h, s, d = q.shape
    n = s // CHUNK
    q = q * d ** -0.5
    rc = lambda t: t.reshape(b, h, n, CHUNK, *t.shape[3:])
    q, k, v, beta, g = (rc(t) for t in (q, k, v, beta, g))
    gc = jnp.cumsum(g, axis=-1)
    tri_incl = jnp.tril(jnp.ones((CHUNK, CHUNK), bool))
    tri_strict = jnp.tril(jnp.ones((CHUNK, CHUNK), bool), -1)
    decay_mat = jnp.where(tri_incl, jnp.exp(jnp.where(tri_incl, gc[..., :, None] - gc[..., None, :], 0.0)), 0.0)
    k_beta = k * beta[..., None]
    v_beta = v * beta[..., None]
    a = jnp.where(tri_strict, jnp.einsum('bhnid,bhnjd->bhnij', k_beta, k) * decay_mat, 0.0)
    lhs = jnp.eye(CHUNK, dtype=jnp.float32) + a
    rhs = jnp.concatenate([v_beta, k_beta * jnp.exp(gc)[..., None]], axis=-1)
    sol = lax.linalg.triangular_solve(lhs, rhs, left_side=True, lower=True)
    u, w = sol[..., :d], sol[..., d:]
    attn_intra = jnp.einsum('bhnid,bhnjd->bhnij', q, k) * decay_mat
    q_dec = q * jnp.exp(gc)[..., None]
    k_dec = k * jnp.exp(gc[..., -1:] - gc)[..., None]
    g_last = jnp.exp(gc[..., -1])

    def step(state, inp):
        u_c, w_c, qd_c, kd_c, at_c, gl_c = inp
        v_new = u_c - jnp.einsum('bhcd,bhde->bhce', w_c, state)
        o = jnp.einsum('bhcd,bhde->bhce', qd_c, state) + jnp.einsum('bhij,bhje->bhie', at_c, v_new)
        state = state * gl_c[..., None, None] + jnp.einsum('bhcd,bhce->bhde', kd_c, v_new)
        return state, o

    xs = tuple(jnp.moveaxis(t, 2, 0) for t in (u, w, q_dec, k_dec, attn_intra, g_last))
    _, o = lax.scan(step, jnp.zeros((b, h, d, d), jnp.float32), xs)
    return jnp.moveaxis(o, 0, 2).reshape(b, h, s, d)


def forgetting_attention(q, k, v, log_f):
    b, h, s, d = q.shape
    nb = s // Q_BLOCK
    c = jnp.cumsum(log_f, axis=-1)
    qb = q.reshape(b, h, nb, Q_BLOCK, d).transpose(2, 0, 1, 3, 4)
    cb = c.reshape(b, h, nb, Q_BLOCK).transpose(2, 0, 1, 3)
    pos_k = jnp.arange(s)

    def block(args):
        i, q_i, c_i = args
        pos_q = i * Q_BLOCK + jnp.arange(Q_BLOCK)
        logits = jnp.einsum('bhqd,bhkd->bhqk', q_i, k).astype(jnp.float32) * d ** -0.5
        logits = logits + (c_i[..., :, None] - c[..., None, :])
        logits = jnp.where(pos_k[None, :] <= pos_q[:, None], logits, -jnp.inf)
        p = jax.nn.softmax(logits, axis=-1)
        return jnp.einsum('bhqk,bhkd->bhqd', p.astype(v.dtype), v)

    o = lax.map(block, (jnp.arange(nb), qb, cb))
    return o.transpose(1, 2, 0, 3, 4).reshape(b, h, s, d)


def stick_breaking_attention(q, k, v):
    b, h, s, d = q.shape
    nb = s // Q_BLOCK
    qb = q.reshape(b, h, nb, Q_BLOCK, d).transpose(2, 0, 1, 3, 4)
    pos_k = jnp.arange(s)

    def block(args):
        i, q_i = args
        pos_q = i * Q_BLOCK + jnp.arange(Q_BLOCK)
        z = jnp.einsum('bhqd,bhkd->bhqk', q_i, k).astype(jnp.float32) * d ** -0.5
        before = pos_k[None, :] < pos_q[:, None]
        log_1m = jnp.where(before, jax.nn.log_sigmoid(-z), 0.0)
        tail = lax.cumsum(log_1m, axis=3, reverse=True) - log_1m
        a = jnp.where(before, jnp.exp(jax.nn.log_sigmoid(z) + tail), 0.0)
        return jnp.einsum('bhqk,bhkd->bhqd', a.astype(v.dtype), v)

    o = lax.map(block, (jnp.arange(nb), qb))
    return o.transpose(1, 2, 0, 3, 4).reshape(b, h, s, d)


def deltanet_fox_mixer(h, w_in, conv_w, a_log, dt_bias, dn_norm_g, q_norm_g, k_norm_g, f_bias, w_out):
    dn_qkv, dn_gate, dn_b, dn_a, fq, fk, fv, f_gate, f_pre = _split(h @ w_in, EVEN_SPLITS)
    dq, dk, dv = jnp.split(causal_conv_silu(dn_qkv, conv_w), 3, axis=-1)
    dq = l2norm(split_heads(dq, N_DN_HEADS))
    dk = l2norm(split_heads(dk, N_DN_HEADS))
    dv = split_heads(dv, N_DN_HEADS).astype(jnp.float32)
    beta = jax.nn.sigmoid(dn_b.astype(jnp.float32)).transpose(0, 2, 1)
    g = (-jnp.exp(a_log.astype(jnp.float32)) * jax.nn.softplus(dn_a.astype(jnp.float32) + dt_bias.astype(jnp.float32))).transpose(0, 2, 1)
    o_dn = gated_delta_rule(dq, dk, dv, beta, g).astype(h.dtype)
    o_dn = merge_heads(rmsnorm(o_dn, dn_norm_g)) * jax.nn.silu(dn_gate)
    fq = rmsnorm(split_heads(fq, N_FOX_HEADS), q_norm_g)
    fk = rmsnorm(split_heads(fk, N_FOX_HEADS), k_norm_g)
    fv = split_heads(fv, N_FOX_HEADS)
    log_f = jax.nn.log_sigmoid(f_pre.astype(jnp.float32) + f_bias.astype(jnp.float32)).transpose(0, 2, 1)
    o_fox = merge_heads(forgetting_attention(fq, fk, fv, log_f)) * jax.nn.sigmoid(f_gate)
    return jnp.concatenate([o_dn, o_fox], axis=-1) @ w_out


def stick_breaking_mixer(h, w_in, w_out):
    q, k, v = jnp.split(h @ w_in, 3, axis=-1)
    o = stick_breaking_attention(split_heads(q, N_SB_HEADS), split_heads(k, N_SB_HEADS), split_heads(v, N_SB_HEADS))
    return merge_heads(o) @ w_out


def setup_inputs(seed: int = 0) -> dict:
    key = jax.random.key(seed)
    ks = jax.random.split(key, 20)
    f32 = jnp.float32

    def w(k, shape, fan_in):
        return jax.random.normal(k, shape, f32) * fan_in ** -0.5

    def gain(k, shape):
        return 1.0 + 0.02 * jax.random.normal(k, shape, f32)

    dt = jnp.exp(jax.random.uniform(ks[8], (N_EVEN, N_DN_HEADS), f32, math.log(1e-3), math.log(1e-1)))
    return {
        'x': jax.random.normal(ks[0], (BATCH, SEQ, D_MODEL), f32),
        'norm_ffn1': gain(ks[1], (DEPTH, D_MODEL)),
        'ffn1_w_gu': w(ks[2], (DEPTH, D_MODEL, 2 * D_FF), D_MODEL),
        'ffn1_w_down': w(ks[3], (DEPTH, D_FF, D_MODEL), D_FF),
        'norm_mix': gain(ks[4], (DEPTH, D_MODEL)),
        'w_in_even': w(ks[5], (N_EVEN, D_MODEL, D_IN_EVEN), D_MODEL),
        'dn_conv_w': w(ks[6], (N_EVEN, CONV_WIDTH, 3 * D_DN), CONV_WIDTH),
        'dn_a_log': jnp.log(jax.random.uniform(ks[7], (N_EVEN, N_DN_HEADS), f32, 1.0, 16.0)),
        'dn_dt_bias': dt + jnp.log(-jnp.expm1(-dt)),
        'dn_norm_g': gain(ks[9], (N_EVEN, HEAD_DIM)),
        'fox_q_norm_g': gain(ks[10], (N_EVEN, HEAD_DIM)),
        'fox_k_norm_g': gain(ks[11], (N_EVEN, HEAD_DIM)),
        'fox_f_bias': jax.random.uniform(ks[12], (N_EVEN, N_FOX_HEADS), f32, 1.0, 4.0),
        'w_out_even': w(ks[13], (N_EVEN, D_DN + D_FOX, D_MODEL), D_DN + D_FOX),
        'w_in_odd': w(ks[14], (N_ODD, D_MODEL, D_IN_ODD), D_MODEL),
        'w_out_odd': w(ks[15], (N_ODD, N_SB_HEADS * HEAD_DIM, D_MODEL), N_SB_HEADS * HEAD_DIM),
        'norm_ffn2': gain(ks[16], (DEPTH, D_MODEL)),
        'ffn2_w_gu': w(ks[17], (DEPTH, D_MODEL, 2 * D_FF), D_MODEL),
        'ffn2_w_down': w(ks[18], (DEPTH, D_FF, D_MODEL), D_FF),
    }


def reference(x, norm_ffn1, ffn1_w_gu, ffn1_w_down, norm_mix, w_in_even, dn_conv_w, dn_a_log,
              dn_dt_bias, dn_norm_g, fox_q_norm_g, fox_k_norm_g, fox_f_bias, w_out_even,
              w_in_odd, w_out_odd, norm_ffn2, ffn2_w_gu, ffn2_w_down):
    for l in range(DEPTH):
        x = x + 0.5 * swiglu_ffn(rmsnorm(x, norm_ffn1[l]), ffn1_w_gu[l], ffn1_w_down[l])
        h = rmsnorm(x, norm_mix[l])
        j = l // 2
        if l % 2 == 0:
            x = x + deltanet_fox_mixer(h, w_in_even[j], dn_conv_w[j], dn_a_log[j], dn_dt_bias[j],
                                       dn_norm_g[j], fox_q_norm_g[j], fox_k_norm_g[j], fox_f_bias[j],
                                       w_out_even[j])
        else:
            x = x + stick_breaking_mixer(h, w_in_odd[j], w_out_odd[j])
        x = x + 0.5 * swiglu_ffn(rmsnorm(x, norm_ffn2[l]), ffn2_w_gu[l], ffn2_w_down[l])
    return x
```

```cpp
#include <hip/hip_runtime.h>
#include <hip/hip_cooperative_groups.h>
#include <cstdio>
namespace cg = cooperative_groups;
__device__ __forceinline__ int tid_fresh() { int t = threadIdx.x; asm volatile("" : "+v"(t)); return t; }
namespace pg8 {
#define PG8_LAS __attribute__((address_space(3)))
typedef unsigned short bf16_t;
typedef short bf16x8 __attribute__((ext_vector_type(8)));
typedef float f32x4 __attribute__((ext_vector_type(4)));
typedef unsigned u32x4 __attribute__((ext_vector_type(4)));
constexpr int BM = 256, BK = 64, HALF = 128, HTB = HALF * BK * 2  , STAGE_BYTES = 8 * HTB, NXCD = 8, WGM = 8;

__host__ __device__ __forceinline__ int lds_byte(int r, int c) { const int st = (r >> 4) * 2 + (c >> 5), rr = r & 15, cc = c & 31, ob = rr * 64 + cc * 2; return st * 1024 + (ob ^ (((ob >> 9) & 1) << 5)); }
__host__ __device__ __forceinline__ void stage_rc(int b, int& R, int& C) { const int st = b / 1024, sb = b % 1024, swz = sb ^ (((sb >> 9) & 1) << 5); R = (st >> 1) * 16 + swz / 64; C = (st & 1) * 32 + (swz % 64) / 2; }
__host__ __device__ __forceinline__ int perm32(int rho) { const int n = rho >> 4, i = rho & 15; return 8 * (i >> 2) + 4 * n + (i & 3); }

struct Unit { int pm, pn; };
struct Gemm { const bf16_t* A; const bf16_t* Bt; int M, N, K; };

struct StaticOrder {
    int nM, nN, nwg, G, c;
    __host__ __device__ void init(int M, int N, int G_, int c_) { nM = M / BM; nN = N / BM; nwg = nM * nN; G = G_; c = c_; }
    __host__ __device__ bool next(int i, Unit& u) const {
        const long L = (long)i * G + c; if (L >= nwg) return false;
        int wgid = (int)L; { const int q = nwg / NXCD, r = nwg % NXCD, xcd = wgid % NXCD, off = wgid / NXCD; wgid = (xcd < r ? xcd * (q + 1) : r * (q + 1) + (xcd - r) * q) + off; }
        const int nig = WGM * nN, gid = wgid / nig, fm = gid * WGM, gsz = (nM - fm) < WGM ? (nM - fm) : WGM;
        u.pm = fm + ((wgid % nig) % gsz); u.pn = (wgid % nig) / gsz; return true;
    }
    __device__ __forceinline__ void a_ready(const Unit&) const {}
    __device__ __forceinline__ void done(const Unit&) const {}
};
struct CountedOrder : StaticOrder {
    const unsigned* ready; unsigned need; unsigned* tmo;
    __device__ __forceinline__ void a_ready(const Unit& u) const {
        if (threadIdx.x < 64) {
            const unsigned long long t0 = __builtin_amdgcn_s_memrealtime(); unsigned polls = 0;
            while ((unsigned)__builtin_amdgcn_readfirstlane(__hip_atomic_load(ready + 64 * u.pm, __ATOMIC_RELAXED, __HIP_MEMORY_SCOPE_AGENT)) < need) {
                if ((++polls & 255u) == 0u && __builtin_amdgcn_readfirstlane(__hip_atomic_load(tmo, __ATOMIC_RELAXED, __HIP_MEMORY_SCOPE_AGENT)) != 0u) break;
                if (__builtin_amdgcn_s_memrealtime() - t0 > 2000000ull) {
                    if (threadIdx.x == 0) { unsigned expect = 0u; __hip_atomic_compare_exchange_strong(tmo + 1, &expect, 0x600u | (unsigned)(u.pm & 0xff), __ATOMIC_RELAXED, __ATOMIC_RELAXED, __HIP_MEMORY_SCOPE_AGENT); __hip_atomic_store(tmo, 1u, __ATOMIC_RELAXED, __HIP_MEMORY_SCOPE_AGENT); }
                    break; }
                __builtin_amdgcn_s_sleep(2); }
            __builtin_amdgcn_fence(__ATOMIC_ACQUIRE, "agent");
            asm volatile("s_waitcnt vmcnt(0)" ::: "memory");
        }
#if !defined(BROKEN_HOOK_NO_BARRIER)
        asm volatile("" ::: "memory"); __builtin_amdgcn_s_barrier(); asm volatile("" ::: "memory");
#endif
    }
};

__device__ __forceinline__ unsigned cvt_pk_bf16(float lo, float hi) { unsigned r; asm volatile("v_cvt_pk_bf16_f32 %0, %1, %2" : "=v"(r) : "v"(lo), "v"(hi)); return r; }

template <class Epi, class Sched, bool STAMP = false>
__device__ __forceinline__ void gemm_phase(PG8_LAS unsigned char* lds, const Gemm g, const Sched& S, const Epi& E, unsigned long long* stamps) {
    const int tid = tid_fresh(), wid = __builtin_amdgcn_readfirstlane(tid >> 6), lane = tid & 63, wr = wid >> 2, wc = wid & 3, fr = lane & 15, fq = lane >> 4;
    const int K = g.K, nt = K / BK;
    int ts_lo = 0, ts_hi = 0, nts = 0; const unsigned long long rt_entry = STAMP ? (unsigned long long)wall_clock64() : 0ull;
#define PG8_STAMP() do { if (STAMP && wid == 0 && nts < 64) { const unsigned long long _c = (unsigned long long)clock64(); \
        ts_lo = (lane == nts) ? (int)(unsigned)_c : ts_lo; ts_hi = (lane == nts) ? (int)(unsigned)(_c >> 32) : ts_hi; ++nts; } } while (0)
    PG8_STAMP();
    unsigned voffA[2], voffB[2];
#pragma unroll
    for (int i = 0; i < 2; ++i) { int R, C; stage_rc(tid * 16 + i * 8192, R, C); const int Rb = E.perm() ? ((R & ~31) + perm32(R & 31)) : R;
        voffA[i] = (unsigned)(R * K + C) * 2u; voffB[i] = (unsigned)(Rb * K + C) * 2u; }
    const size_t kstep = (size_t)(BK * 2);
    const size_t hstep = (size_t)HALF * K * 2;
    const size_t tstep = 2 * hstep;
    const unsigned ldsw = (unsigned)wid * 1024u;
    const int aoff = lds_byte(wr * 64 + fr, fq * 8), boff = lds_byte(wc * 32 + fr, fq * 8);
#define PG8_SA(b, h) (((b) * 2 + (h)) * HTB)
#define PG8_SB(b, h) ((4 + (b) * 2 + (h)) * HTB)
#define PG8_STAGE(bufoff, gbase, voff) do { _Pragma("unroll") for (int _i = 0; _i < 2; ++_i) \
        __builtin_amdgcn_global_load_lds((const unsigned*)((const char*)(gbase) + (voff)[_i]), (PG8_LAS unsigned*)(lds + (bufoff) + ldsw + _i * 8192), 16, 0, 0); } while (0)
#define PG8_LDA(dst, b, h) do { _Pragma("unroll") for (int m = 0; m < 4; ++m) _Pragma("unroll") for (int k = 0; k < 2; ++k) dst[m][k] = *(const PG8_LAS bf16x8*)(lds + PG8_SA(b, h) + aoff + m * 2048 + k * 1024); } while (0)
#define PG8_LDB(dst, b, h) do { _Pragma("unroll") for (int n = 0; n < 2; ++n) _Pragma("unroll") for (int k = 0; k < 2; ++k) dst[n][k] = *(const PG8_LAS bf16x8*)(lds + PG8_SB(b, h) + boff + n * 2048 + k * 1024); } while (0)
#define PG8_MMA(ai, bj, At, Bt) do { __builtin_amdgcn_s_setprio(1); _Pragma("unroll") for (int m = 0; m < 4; ++m) _Pragma("unroll") for (int n = 0; n < 2; ++n) _Pragma("unroll") for (int k = 0; k < 2; ++k) \
        acc[ai][bj][m][n] = __builtin_amdgcn_mfma_f32_16x16x32_bf16(Bt[n][k], At[m][k], acc[ai][bj][m][n], 0, 0, 0); __builtin_amdgcn_s_setprio(0); } while (0)
#define PG8_WAIT_V(n) asm volatile("s_waitcnt vmcnt(" #n ")" ::: "memory")
#define PG8_WAIT_L(n) asm volatile("s_waitcnt lgkmcnt(" #n ")" ::: "memory")
#define PG8_BAR __builtin_amdgcn_s_barrier()
#define PG8_SCHED __builtin_amdgcn_sched_barrier(0)
    Unit cur, nxt; int ui = 0;
    if (!S.next(0, cur)) return;
    f32x4 acc[2][2][4][2];
#pragma unroll
    for (int a = 0; a < 2; ++a)
#pragma unroll
        for (int b = 0; b < 2; ++b)
#pragma unroll
            for (int m = 0; m < 4; ++m)
#pragma unroll
                for (int n = 0; n < 2; ++n) acc[a][b][m][n] = (f32x4){0.f, 0.f, 0.f, 0.f};
    bf16x8 At[4][2], B0[2][2], B1[2][2];
    const char* cA = (const char*)g.A + (size_t)cur.pm * tstep; const char* cB = (const char*)g.Bt + (size_t)cur.pn * tstep;
    S.a_ready(cur);
    PG8_STAGE(PG8_SB(0, 0), cB, voffB); PG8_STAGE(PG8_SA(0, 0), cA, voffA); PG8_STAGE(PG8_SB(0, 1), cB + hstep, voffB); PG8_STAGE(PG8_SA(0, 1), cA + hstep, voffA);
    if (wr == 1) PG8_BAR;
    PG8_WAIT_V(4); PG8_BAR;
    PG8_STAGE(PG8_SB(1, 0), cB + kstep, voffB); PG8_STAGE(PG8_SA(1, 0), cA + kstep, voffA); PG8_STAGE(PG8_SB(1, 1), cB + hstep + kstep, voffB);
    PG8_WAIT_V(6); PG8_BAR;
    PG8_STAMP();
    for (;;) {
        const bool has_next = S.next(ui + 1, nxt);
        const char* nA = has_next ? (const char*)g.A + (size_t)nxt.pm * tstep : cA; const char* nB = has_next ? (const char*)g.Bt + (size_t)nxt.pn * tstep : cB;
        for (int t = 0; t < nt; t += 2) {
            const bool last = (t == nt - 2);
            const char* a1 = cA + (size_t)(t + 1) * kstep;
            const char* a2 = last ? nA : cA + (size_t)(t + 2) * kstep; const char* b2 = last ? nB : cB + (size_t)(t + 2) * kstep;
            const char* a3 = a2 + kstep; const char* b3 = b2 + kstep;
            if (last && has_next) S.a_ready(nxt);
            PG8_LDB(B0, 0, 0); PG8_SCHED; PG8_LDA(At, 0, 0); PG8_STAGE(PG8_SA(1, 1), a1 + hstep, voffA);
            PG8_WAIT_L(8); PG8_BAR; PG8_WAIT_L(0); PG8_MMA(0, 0, At, B0); PG8_BAR; PG8_SCHED;
            PG8_LDB(B1, 0, 1); PG8_STAGE(PG8_SB(0, 0), b2, voffB);
            PG8_BAR; PG8_WAIT_L(0); PG8_MMA(0, 1, At, B1); PG8_BAR;
            PG8_LDA(At, 0, 1); PG8_STAGE(PG8_SA(0, 0), a2, voffA);
            PG8_BAR; PG8_WAIT_L(0); PG8_MMA(1, 0, At, B0); PG8_BAR; PG8_SCHED;
            PG8_STAGE(PG8_SB(0, 1), b2 + hstep, voffB);
            PG8_WAIT_V(6); PG8_BAR; PG8_MMA(1, 1, At, B1); PG8_BAR;
            PG8_LDB(B0, 1, 0); PG8_SCHED; PG8_LDA(At, 1, 0); PG8_STAGE(PG8_SA(0, 1), a2 + hstep, voffA);
            PG8_WAIT_L(8); PG8_BAR; PG8_WAIT_L(0); PG8_MMA(0, 0, At, B0); PG8_BAR; PG8_SCHED;
            PG8_LDB(B1, 1, 1); PG8_STAGE(PG8_SB(1, 0), b3, voffB);
            PG8_BAR; PG8_WAIT_L(0); PG8_MMA(0, 1, At, B1); PG8_BAR;
            PG8_LDA(At, 1, 1); PG8_STAGE(PG8_SA(1, 0), a3, voffA);
            PG8_BAR; PG8_WAIT_L(0); PG8_MMA(1, 0, At, B0); PG8_BAR; PG8_SCHED;
            PG8_STAGE(PG8_SB(1, 1), b3 + hstep, voffB);
            PG8_WAIT_V(6); PG8_BAR; PG8_MMA(1, 1, At, B1); PG8_BAR;
        }
        PG8_STAMP();
        if constexpr (!Epi::AFTER_DRAIN) { E(acc, cur, wr, wc, fr, fq); S.done(cur); }
        PG8_STAMP();
        if (!has_next) break;
#pragma unroll
        for (int a = 0; a < 2; ++a)
#pragma unroll
            for (int b = 0; b < 2; ++b)
#pragma unroll
                for (int m = 0; m < 4; ++m)
#pragma unroll
                    for (int n = 0; n < 2; ++n) acc[a][b][m][n] = (f32x4){0.f, 0.f, 0.f, 0.f};
        cur = nxt; cA = nA; cB = nB; ++ui;
    }
    PG8_WAIT_V(0);
    if (wr == 0) PG8_BAR;
    PG8_BAR;
    if constexpr (Epi::AFTER_DRAIN) { E.fused(acc, cur, wr, wc, fr, fq, lds, wid, lane); S.done(cur); }
    PG8_STAMP();
    if (STAMP && wid == 0) { stamps[lane] = lane < nts ? (((unsigned long long)(unsigned)ts_hi << 32) | (unsigned)ts_lo) : 0ull;
        if (lane == 62) stamps[62] = rt_entry; if (lane == 63) stamps[63] = (unsigned long long)wall_clock64(); }
#undef PG8_STAMP
#undef PG8_SA
#undef PG8_SB
#undef PG8_STAGE
#undef PG8_LDA
#undef PG8_LDB
#undef PG8_MMA
#undef PG8_WAIT_V
#undef PG8_WAIT_L
#undef PG8_BAR
#undef PG8_SCHED
}
}

using pg8::bf16_t; using pg8::bf16x8; using pg8::f32x4; using pg8::u32x4;
typedef unsigned u32x2 __attribute__((ext_vector_type(2)));

constexpr int T = 16384, DM = 1024, FF = 2816, SEQ = 4096;
constexpr float EPS = 1e-6f;
constexpr float QSCALE = 0.08838834764831845f;

constexpr size_t SZ_GU = (size_t)5632 * 1024 * 2, SZ_DN = (size_t)1024 * 2816 * 2;
constexpr size_t WS_CTL = 0;
constexpr size_t WS_GU1 = 4096;
constexpr size_t WS_DN1 = WS_GU1 + SZ_GU;
constexpr size_t WS_GU2 = WS_DN1 + SZ_DN;
constexpr size_t WS_DN2 = WS_GU2 + SZ_GU;
constexpr size_t WS_WIN = WS_DN2 + SZ_DN;
constexpr size_t WS_WOUT = WS_WIN + (size_t)4096 * 1024 * 2;
constexpr size_t WS_XN = WS_WOUT + (size_t)1024 * 1024 * 2;
constexpr size_t WS_BIG = WS_XN + (size_t)T * 1024 * 2;
constexpr size_t WS_VT = WS_BIG + (size_t)T * 3584 * 2;
constexpr size_t WS_OB = WS_VT + (size_t)1024 * T * 2;
constexpr size_t WS_SM = WS_OB + (size_t)T * 1024 * 2;
constexpr size_t WS_CF = WS_SM + (size_t)T * 16 * 4;
constexpr size_t WS_GL = WS_CF + (size_t)16 * 4096 * 4;
constexpr size_t WS_DNX = WS_GL + 4096;
constexpr size_t DNX_UNIT = 73728;
constexpr size_t WS_END = WS_DNX + 1024 * DNX_UNIT;
constexpr int LDS_BYTES = 152 * 1024;

__device__ __forceinline__ float bf2f(unsigned short b) { return __uint_as_float(((unsigned)b) << 16); }
__device__ __forceinline__ float bflo(unsigned w) { return __uint_as_float(w << 16); }
__device__ __forceinline__ float bfhi(unsigned w) { return __uint_as_float(w & 0xffff0000u); }
typedef __bf16 bf16v2_t __attribute__((ext_vector_type(2)));
typedef float f32v2_t __attribute__((ext_vector_type(2)));
__device__ __forceinline__ unsigned pk2(float lo, float hi) { const f32v2_t f = {lo, hi}; const bf16v2_t v = __builtin_convertvector(f, bf16v2_t); return __builtin_bit_cast(unsigned, v); }
__device__ __forceinline__ float fast_rcp(float x) { return __builtin_amdgcn_rcpf(x); }
__device__ __forceinline__ float sigmoid_(float x) { return fast_rcp(1.f + __expf(-x)); }
__device__ __forceinline__ float silu_(float x) { return x * sigmoid_(x); }
__device__ __forceinline__ float softplus_(float x) { return fmaxf(x, 0.f) + __logf(1.f + __expf(-fabsf(x))); }
__device__ __forceinline__ float wave_sum(float v) {
#pragma unroll
  for (int o = 32; o; o >>= 1) v += __shfl_xor(v, o);
  return v;
}

struct EpiAny {
  static constexpr bool AFTER_DRAIN = false;
  int mode; void* P; int ldc; float scale;
  __device__ __forceinline__ bool perm() const { return mode != 1; }
  __device__ __forceinline__ void operator()(const f32x4 (&acc)[2][2][4][2], const pg8::Unit& u, int wr, int wc, int fr, int fq) const {
    if (mode == 0) {
      bf16_t* O = (bf16_t*)P;
      const int row0 = u.pm * 256 + wr * 64 + fr, col0 = u.pn * 128 + wc * 32 + 8 * fq;
#pragma unroll
      for (int ai = 0; ai < 2; ++ai)
#pragma unroll
        for (int m = 0; m < 4; ++m) {
          bf16_t* rowp = O + (size_t)(row0 + ai * 128 + m * 16) * ldc + col0;
          float r[8];
#pragma unroll
          for (int n = 0; n < 2; ++n)
#pragma unroll
            for (int j = 0; j < 4; ++j) { const float g = acc[ai][0][m][n][j], up = acc[ai][1][m][n][j]; r[n * 4 + j] = silu_(g) * up; }
          u32x4 w; w.x = pk2(r[0], r[1]); w.y = pk2(r[2], r[3]); w.z = pk2(r[4], r[5]); w.w = pk2(r[6], r[7]);
          *(u32x4*)rowp = w;
        }
    } else if (mode == 1) {
      float* X = (float*)P;
      const int row0 = u.pm * 256 + wr * 64 + fr, col0 = u.pn * 256 + wc * 32 + 4 * fq;
#pragma unroll
      for (int ai = 0; ai < 2; ++ai)
#pragma unroll
        for (int m = 0; m < 4; ++m) {
          float* rowp = X + (size_t)(row0 + ai * 128 + m * 16) * ldc + col0;
#pragma unroll
          for (int bj = 0; bj < 2; ++bj)
#pragma unroll
            for (int n = 0; n < 2; ++n) { f32x4* p = (f32x4*)(rowp + bj * 128 + n * 16); f32x4 v = *p; v = v + acc[ai][bj][m][n] * scale; *p = v; }
        }
    } else {
      bf16_t* O = (bf16_t*)P;
      const int row0 = u.pm * 256 + wr * 64 + fr, col0 = u.pn * 256 + wc * 32 + 8 * fq;
#pragma unroll
      for (int ai = 0; ai < 2; ++ai)
#pragma unroll
        for (int m = 0; m < 4; ++m) {
          bf16_t* rowp = O + (size_t)(row0 + ai * 128 + m * 16) * ldc + col0;
#pragma unroll
          for (int bj = 0; bj < 2; ++bj) {
            const f32x4 v0 = acc[ai][bj][m][0], v1 = acc[ai][bj][m][1];
            u32x4 w; w.x = pk2(v0[0], v0[1]); w.y = pk2(v0[2], v0[3]); w.z = pk2(v1[0], v1[1]); w.w = pk2(v1[2], v1[3]);
            *(u32x4*)(rowp + bj * 128) = w;
          }
        }
    }
  }
};

__device__ __forceinline__ void transpose_job(float* sT, const float* src, int ld, int K, int ncols, bf16_t* dst, int rs, int roff, int& rot) {
  const int tid = tid_fresh(), G = gridDim.x;
  const int ntn = ncols >> 6, ntiles = (K >> 6) * ntn;
  int first = (int)blockIdx.x - rot; if (first < 0) first += G;
  for (int t = first; t < ntiles; t += G) {
    const int kt = t / ntn, nt = t - kt * ntn; const int k0 = kt * 64, n0 = nt * 64;
    { const int r = tid >> 4, c4 = (tid & 15) * 4;
#pragma unroll
      for (int i = 0; i < 2; ++i) { const float4 v = *(const float4*)(src + (size_t)(k0 + r + 32 * i) * ld + n0 + c4); float* p = sT + (r + 32 * i) * 65 + c4; p[0] = v.x; p[1] = v.y; p[2] = v.z; p[3] = v.w; } }
    __syncthreads();
    { const int n = tid >> 3, ks = (tid & 7) * 8; const float* p = sT + ks * 65 + n;
      u32x4 w; w.x = pk2(p[0], p[65]); w.y = pk2(p[130], p[195]); w.z = pk2(p[260], p[325]); w.w = pk2(p[390], p[455]);
      const int na = n0 + n; const int row = roff + (na >> 7) * rs + (na & 127);
      *(u32x4*)(dst + (size_t)row * K + k0 + ks) = w; }
    __syncthreads();
  }
  rot = (rot + ntiles) % G;
}

template <bool SMALL>
__device__ __forceinline__ void norm_phase(unsigned char* lds, const float* xsrc, float* xcopy, const float* gain, bf16_t* XN,
                                           const float* w_in, const float* a_log, const float* dt_bias, const float* f_bias, float* SM) {
  const int tid = tid_fresh(), lane = tid & 63, wave = tid >> 6;
  float* ws_s = (float*)lds;
  if (SMALL) {
    for (int e = tid; e < 12288; e += 512) { const int k = e / 12, c = e - k * 12; const int col = c < 8 ? 2048 + c : 4096 + c; ws_s[c * 1024 + k] = w_in[(size_t)k * 4108 + col]; }
    __syncthreads();
  }
  float4 gv[4];
#pragma unroll
  for (int j = 0; j < 4; ++j) gv[j] = *(const float4*)(gain + lane * 4 + 256 * j);
  for (int row = blockIdx.x * 8 + wave; row < T; row += gridDim.x * 8) {
    float4 xv[4]; float ss = 0.f;
#pragma unroll
    for (int j = 0; j < 4; ++j) { xv[j] = *(const float4*)(xsrc + (size_t)row * 1024 + lane * 4 + 256 * j); ss += xv[j].x * xv[j].x + xv[j].y * xv[j].y + xv[j].z * xv[j].z + xv[j].w * xv[j].w; }
    if (xcopy) {
#pragma unroll
      for (int j = 0; j < 4; ++j) *(float4*)(xcopy + (size_t)row * 1024 + lane * 4 + 256 * j) = xv[j];
    }
    ss = wave_sum(ss);
    const float rstd = rsqrtf(ss * (1.f / 1024.f) + EPS);
#pragma unroll
    for (int j = 0; j < 4; ++j) {
      xv[j].x = xv[j].x * rstd * gv[j].x; xv[j].y = xv[j].y * rstd * gv[j].y; xv[j].z = xv[j].z * rstd * gv[j].z; xv[j].w = xv[j].w * rstd * gv[j].w;
      u32x2 w; w.x = pk2(xv[j].x, xv[j].y); w.y = pk2(xv[j].z, xv[j].w);
      *(u32x2*)(XN + (size_t)row * 1024 + lane * 4 + 256 * j) = w;
    }
    if (SMALL) {
      float mine = 0.f;
#pragma unroll
      for (int c = 0; c < 12; ++c) {
        float d = 0.f;
#pragma unroll
        for (int j = 0; j < 4; ++j) { const float4 wv = *(const float4*)(ws_s + c * 1024 + lane * 4 + 256 * j); d += xv[j].x * wv.x + xv[j].y * wv.y + xv[j].z * wv.z + xv[j].w * wv.w; }
        d = wave_sum(d);
        mine = (lane == c) ? d : mine;
        __builtin_amdgcn_sched_barrier(0);
      }
      if (lane < 12) {
        const int h = lane & 3; float o;
        if (lane < 4) o = sigmoid_(mine);
        else if (lane < 8) o = -__expf(a_log[h]) * softplus_(mine + dt_bias[h]);
        else o = -softplus_(-(mine + f_bias[h]));
        SM[(size_t)row * 16 + lane] = o;
      }
    }
  }
  if (SMALL) __syncthreads();
}

__device__ __forceinline__ void cumsum_logf(unsigned char* lds, const float* SM, float* CF) {
  if (blockIdx.x < 16) {
    const int tid = tid_fresh(), lane = tid & 63, wave = tid >> 6;
    const int seq = blockIdx.x, b = seq >> 2, h = seq & 3; float* red = (float*)lds;
    float v[8]; float run = 0.f;
#pragma unroll
    for (int e = 0; e < 8; ++e) { run += SM[((size_t)(b * 4096 + tid * 8 + e)) * 16 + 8 + h]; v[e] = run; }
    float sc = run;
#pragma unroll
    for (int o = 1; o < 64; o <<= 1) { const float t = __shfl_up(sc, o); if (lane >= o) sc += t; }
    if (lane == 63) red[wave] = sc;
    __syncthreads();
    float base = sc - run;
    for (int w2 = 0; w2 < wave; ++w2) base += red[w2];
#pragma unroll
    for (int e = 0; e < 8; ++e) CF[seq * 4096 + tid * 8 + e] = v[e] + base;
    __syncthreads();
  }
}

#define MFMA16(a, b, c) __builtin_amdgcn_mfma_f32_16x16x32_bf16((a), (b), (c), 0, 0, 0)

__device__ __forceinline__ void dn_prep_unit(unsigned char* lds, int u, const bf16_t* BIG, const float* SM, const float* convw, unsigned char* DNX, float* GL) {
  const int tid = tid_fresh(), lane = tid & 63, wave = tid >> 6;
  bf16_t* q_s = (bf16_t*)lds; bf16_t* k_s = (bf16_t*)(lds + 17408); float* A_s = (float*)(lds + 34816);
  float* gc_s = (float*)(lds + 52224); float* beta_s = (float*)(lds + 52480); float* rhs = (float*)(lds + 52736);
  const int bh = u >> 6, n = u & 63, b = bh >> 2, h = bh & 3; const int t0 = b * SEQ + n * 64;
  unsigned char* ux = DNX + (size_t)u * DNX_UNIT;
  bf16_t* UT = (bf16_t*)ux; bf16_t* Wd = (bf16_t*)(ux + 16384); bf16_t* QD = (bf16_t*)(ux + 32768); bf16_t* KDT = (bf16_t*)(ux + 49152); bf16_t* AT = (bf16_t*)(ux + 65536);
  if (tid < 64) {
    float g = SM[(size_t)(t0 + tid) * 16 + 4 + h];
#pragma unroll
    for (int o = 1; o < 64; o <<= 1) { const float t = __shfl_up(g, o); if (lane >= o) g += t; }
    gc_s[tid] = g; beta_s[tid] = SM[(size_t)(t0 + tid) * 16 + h];
    if (tid == 63) GL[u] = __expf(g);
  }
  __syncthreads();
  {
    const int s = tid >> 3, c0 = (tid & 7) * 16;
    const float bs = beta_s[s], eg = __expf(gc_s[s]);
#pragma unroll
    for (int sel = 0; sel < 3; ++sel) {
      const int col = sel * 512 + h * 128 + c0;
      float a[16];
#pragma unroll
      for (int e = 0; e < 16; ++e) a[e] = 0.f;
#pragma unroll
      for (int i = 0; i < 4; ++i) {
        const int sr = n * 64 + s - 3 + i;
        if (sr >= 0) {
          const bf16_t* xp = BIG + (size_t)(b * SEQ + sr) * 3584 + col;
          const u32x4 x0 = *(const u32x4*)xp, x1 = *(const u32x4*)(xp + 8);
          const float* wp = convw + i * 1536 + col;
          const float4 w0 = *(const float4*)wp, w1 = *(const float4*)(wp + 4), w2 = *(const float4*)(wp + 8), w3 = *(const float4*)(wp + 12);
          a[0] += bflo(x0.x) * w0.x; a[1] += bfhi(x0.x) * w0.y; a[2] += bflo(x0.y) * w0.z; a[3] += bfhi(x0.y) * w0.w;
          a[4] += bflo(x0.z) * w1.x; a[5] += bfhi(x0.z) * w1.y; a[6] += bflo(x0.w) * w1.z; a[7] += bfhi(x0.w) * w1.w;
          a[8] += bflo(x1.x) * w2.x; a[9] += bfhi(x1.x) * w2.y; a[10] += bflo(x1.y) * w2.z; a[11] += bfhi(x1.y) * w2.w;
          a[12] += bflo(x1.z) * w3.x; a[13] += bfhi(x1.z) * w3.y; a[14] += bflo(x1.w) * w3.z; a[15] += bfhi(x1.w) * w3.w;
        }
      }
      float ss = 0.f;
#pragma unroll
      for (int e = 0; e < 16; ++e) { a[e] = silu_(a[e]); ss += a[e] * a[e]; }
      if (sel < 2) {
        ss += __shfl_xor(ss, 1); ss += __shfl_xor(ss, 2); ss += __shfl_xor(ss, 4);
        const float r = rsqrtf(ss + EPS) * (sel == 0 ? QSCALE : 1.f);
#pragma unroll
        for (int e = 0; e < 16; ++e) a[e] *= r;
        bf16_t* dsts = (sel == 0 ? q_s : k_s) + s * 136 + c0;
        u32x4 p0, p1;
        p0.x = pk2(a[0], a[1]); p0.y = pk2(a[2], a[3]); p0.z = pk2(a[4], a[5]); p0.w = pk2(a[6], a[7]);
        p1.x = pk2(a[8], a[9]); p1.y = pk2(a[10], a[11]); p1.z = pk2(a[12], a[13]); p1.w = pk2(a[14], a[15]);
        *(u32x4*)dsts = p0; *(u32x4*)(dsts + 8) = p1;
        if (sel == 0) {
          u32x4 d0, d1;
          d0.x = pk2(a[0] * eg, a[1] * eg); d0.y = pk2(a[2] * eg, a[3] * eg); d0.z = pk2(a[4] * eg, a[5] * eg); d0.w = pk2(a[6] * eg, a[7] * eg);
          d1.x = pk2(a[8] * eg, a[9] * eg); d1.y = pk2(a[10] * eg, a[11] * eg); d1.z = pk2(a[12] * eg, a[13] * eg); d1.w = pk2(a[14] * eg, a[15] * eg);
          *(u32x4*)(QD + s * 128 + c0) = d0; *(u32x4*)(QD + s * 128 + c0 + 8) = d1;
        } else {
          const float f = bs * eg; float* rp = rhs + s * 256 + 128 + c0;
#pragma unroll
          for (int e4 = 0; e4 < 4; ++e4) *(float4*)(rp + 4 * e4) = make_float4(a[4 * e4] * f, a[4 * e4 + 1] * f, a[4 * e4 + 2] * f, a[4 * e4 + 3] * f);
        }
      } else {
        float* rp = rhs + s * 256 + c0;
#pragma unroll
        for (int e4 = 0; e4 < 4; ++e4) *(float4*)(rp + 4 * e4) = make_float4(a[4 * e4] * bs, a[4 * e4 + 1] * bs, a[4 * e4 + 2] * bs, a[4 * e4 + 3] * bs);
      }
    }
  }
  __syncthreads();
  {
    const int it = wave & 3, sel = wave >> 2, fr = lane & 15, fq = lane >> 4;
    const bf16_t* As = (sel ? q_s : k_s) + (it * 16 + fr) * 136 + fq * 8;
    bf16x8 af[4];
#pragma unroll
    for (int kk = 0; kk < 4; ++kk) af[kk] = *(const bf16x8*)(As + 32 * kk);
#pragma unroll
    for (int jt = 0; jt < 4; ++jt) {
      f32x4 acc = {0.f, 0.f, 0.f, 0.f};
      if (jt <= it) {
        const bf16_t* Bs = k_s + (jt * 16 + fr) * 136 + fq * 8;
#pragma unroll
        for (int kk = 0; kk < 4; ++kk) acc = MFMA16(af[kk], *(const bf16x8*)(Bs + 32 * kk), acc);
      }
      const int jj = jt * 16 + fr; const float gj = gc_s[jj];
#pragma unroll
      for (int j = 0; j < 4; ++j) {
        const int i = it * 16 + fq * 4 + j;
        const float dec = __expf(fminf(gc_s[i] - gj, 0.f));
        if (sel == 0) A_s[i * 68 + jj] = (i > jj) ? beta_s[i] * acc[j] * dec : 0.f;
        else { const float v = (i >= jj) ? acc[j] * dec : 0.f; AT[i * 64 + jj] = (bf16_t)(pk2(v, 0.f) & 0xffffu); }
      }
    }
  }
  {
    const int d = tid >> 2, sg = (tid & 3) * 16; const float gl = gc_s[63];
    float v[16];
#pragma unroll
    for (int e = 0; e < 16; ++e) v[e] = bf2f(k_s[(sg + e) * 136 + d]) * __expf(gl - gc_s[sg + e]);
    u32x4 p0, p1;
    p0.x = pk2(v[0], v[1]); p0.y = pk2(v[2], v[3]); p0.z = pk2(v[4], v[5]); p0.w = pk2(v[6], v[7]);
    p1.x = pk2(v[8], v[9]); p1.y = pk2(v[10], v[11]); p1.z = pk2(v[12], v[13]); p1.w = pk2(v[14], v[15]);
    *(u32x4*)(KDT + d * 64 + sg) = p0; *(u32x4*)(KDT + d * 64 + sg + 8) = p1;
  }
  __syncthreads();
  if (tid < 256) {
    const int c = tid;
    float x[64];
#pragma unroll
    for (int i = 0; i < 64; ++i) x[i] = rhs[i * 256 + c];
#pragma unroll
    for (int i = 1; i < 64; ++i) {
      float s0 = x[i], s1 = 0.f, s2 = 0.f, s3 = 0.f;
#pragma unroll
      for (int j4 = 0; j4 < (i + 3) / 4; ++j4) {
        const float4 a4 = *(const float4*)(A_s + i * 68 + 4 * j4);
        if (4 * j4 + 0 < i) s0 -= a4.x * x[4 * j4 + 0];
        if (4 * j4 + 1 < i) s1 -= a4.y * x[4 * j4 + 1];
        if (4 * j4 + 2 < i) s2 -= a4.z * x[4 * j4 + 2];
        if (4 * j4 + 3 < i) s3 -= a4.w * x[4 * j4 + 3];
      }
      x[i] = (s0 + s1) + (s2 + s3);
    }
    if (c < 128) {
#pragma unroll
      for (int e = 0; e < 8; ++e) {
        u32x4 p; p.x = pk2(x[8 * e], x[8 * e + 1]); p.y = pk2(x[8 * e + 2], x[8 * e + 3]); p.z = pk2(x[8 * e + 4], x[8 * e + 5]); p.w = pk2(x[8 * e + 6], x[8 * e + 7]);
        *(u32x4*)(UT + c * 64 + 8 * e) = p;
      }
    } else {
#pragma unroll
      for (int i = 0; i < 64; ++i) Wd[i * 128 + (c - 128)] = (bf16_t)(pk2(x[i], 0.f) & 0xffffu);
    }
  }
  __syncthreads();
}

__device__ __forceinline__ void dn_scan(unsigned char* lds, int bh, const unsigned char* DNX, const float* GL, const bf16_t* BIG, const float* ng, bf16_t* OB) {
  const int tid = tid_fresh(), lane = tid & 63, wave = tid >> 6, fr = lane & 15, fq = lane >> 4;
  bf16_t* w_s = (bf16_t*)lds; bf16_t* qd_s = (bf16_t*)(lds + 17408); bf16_t* kdT_s = (bf16_t*)(lds + 34816); bf16_t* at_s = (bf16_t*)(lds + 53248);
  bf16_t* ST_s = (bf16_t*)(lds + 62464); bf16_t* vT_s = (bf16_t*)(lds + 97280); float* o_s = (float*)(lds + 115712);
  const int b = bh >> 2, h = bh & 3;
  for (int e = tid; e < 128 * 136 / 2; e += 512) ((unsigned*)ST_s)[e] = 0u;
  f32x4 Sacc[8];
#pragma unroll
  for (int nt = 0; nt < 8; ++nt) Sacc[nt] = (f32x4){0.f, 0.f, 0.f, 0.f};
  const int r64 = tid >> 4, c16 = (tid & 15) * 8;
  const int r128 = tid >> 3, c8 = (tid & 7) * 8;
  u32x4 rw[2], rq[2], rk[2], ra; u32x2 ru[4];
  const int nrow = wave * 16 + fr;
#define DN_LOAD(nc) do { const unsigned char* ux = DNX + (size_t)((bh << 6) + (nc)) * DNX_UNIT; \
    const bf16_t* UTg = (const bf16_t*)ux; const bf16_t* Wg = (const bf16_t*)(ux + 16384); const bf16_t* QDg = (const bf16_t*)(ux + 32768); \
    const bf16_t* KDTg = (const bf16_t*)(ux + 49152); const bf16_t* ATg = (const bf16_t*)(ux + 65536); \
    _Pragma("unroll") for (int i = 0; i < 2; ++i) { rw[i] = *(const u32x4*)(Wg + (r64 + 32 * i) * 128 + c16); rq[i] = *(const u32x4*)(QDg + (r64 + 32 * i) * 128 + c16); \
      rk[i] = *(const u32x4*)(KDTg + (r128 + 64 * i) * 64 + c8); } \
    ra = *(const u32x4*)(ATg + r128 * 64 + c8); \
    _Pragma("unroll") for (int ct = 0; ct < 4; ++ct) ru[ct] = *(const u32x2*)(UTg + nrow * 64 + ct * 16 + fq * 4); } while (0)
  DN_LOAD(0);
  for (int nc = 0; nc < 64; ++nc) {
#pragma unroll
    for (int i = 0; i < 2; ++i) { *(u32x4*)(w_s + (r64 + 32 * i) * 136 + c16) = rw[i]; *(u32x4*)(qd_s + (r64 + 32 * i) * 136 + c16) = rq[i]; *(u32x4*)(kdT_s + (r128 + 64 * i) * 72 + c8) = rk[i]; }
    *(u32x4*)(at_s + r128 * 72 + c8) = ra;
    u32x2 uc[4];
#pragma unroll
    for (int ct = 0; ct < 4; ++ct) uc[ct] = ru[ct];
    const float gl = GL[(bh << 6) + nc];
    __syncthreads();
    if (nc + 1 < 64) DN_LOAD(nc + 1);
    f32x4 P1[4], P2[4];
    {
      bf16x8 bfr[4];
#pragma unroll
      for (int kk = 0; kk < 4; ++kk) bfr[kk] = *(const bf16x8*)(ST_s + nrow * 136 + fq * 8 + 32 * kk);
#pragma unroll
      for (int ct = 0; ct < 4; ++ct) {
        P1[ct] = (f32x4){0.f, 0.f, 0.f, 0.f}; P2[ct] = (f32x4){0.f, 0.f, 0.f, 0.f};
#pragma unroll
        for (int kk = 0; kk < 4; ++kk) {
          P1[ct] = MFMA16(*(const bf16x8*)(w_s + (ct * 16 + fr) * 136 + fq * 8 + 32 * kk), bfr[kk], P1[ct]);
          P2[ct] = MFMA16(*(const bf16x8*)(qd_s + (ct * 16 + fr) * 136 + fq * 8 + 32 * kk), bfr[kk], P2[ct]);
        }
      }
    }
#pragma unroll
    for (int ct = 0; ct < 4; ++ct) {
      const float v0 = bflo(uc[ct].x) - P1[ct][0], v1 = bfhi(uc[ct].x) - P1[ct][1], v2 = bflo(uc[ct].y) - P1[ct][2], v3 = bfhi(uc[ct].y) - P1[ct][3];
      u32x2 p; p.x = pk2(v0, v1); p.y = pk2(v2, v3);
      *(u32x2*)(vT_s + nrow * 72 + ct * 16 + fq * 4) = p;
    }
    __syncthreads();
    {
      bf16x8 bv[2];
#pragma unroll
      for (int g = 0; g < 2; ++g) bv[g] = *(const bf16x8*)(vT_s + nrow * 72 + fq * 8 + 32 * g);
#pragma unroll
      for (int ct = 0; ct < 4; ++ct) {
#pragma unroll
        for (int g = 0; g < 2; ++g) P2[ct] = MFMA16(*(const bf16x8*)(at_s + (ct * 16 + fr) * 72 + fq * 8 + 32 * g), bv[g], P2[ct]);
#pragma unroll
        for (int j = 0; j < 4; ++j) o_s[(ct * 16 + fq * 4 + j) * 132 + nrow] = P2[ct][j];
      }
    }
    {
      bf16x8 ak[2];
#pragma unroll
      for (int g = 0; g < 2; ++g) ak[g] = *(const bf16x8*)(kdT_s + (wave * 16 + fr) * 72 + fq * 8 + 32 * g);
#pragma unroll
      for (int nt = 0; nt < 8; ++nt) {
        f32x4 a = Sacc[nt] * gl;
#pragma unroll
        for (int g = 0; g < 2; ++g) a = MFMA16(ak[g], *(const bf16x8*)(vT_s + (nt * 16 + fr) * 72 + fq * 8 + 32 * g), a);
        Sacc[nt] = a;
        u32x2 p; p.x = pk2(a[0], a[1]); p.y = pk2(a[2], a[3]);
        *(u32x2*)(ST_s + (nt * 16 + fr) * 136 + wave * 16 + fq * 4) = p;
      }
    }
    __syncthreads();
    {
      const int c = tid >> 3, n0 = (tid & 7) * 16; const int t = b * SEQ + nc * 64 + c;
      float o[16]; float ss = 0.f;
#pragma unroll
      for (int e4 = 0; e4 < 4; ++e4) { const float4 v = *(const float4*)(o_s + c * 132 + n0 + 4 * e4); o[4 * e4] = v.x; o[4 * e4 + 1] = v.y; o[4 * e4 + 2] = v.z; o[4 * e4 + 3] = v.w; ss += v.x * v.x + v.y * v.y + v.z * v.z + v.w * v.w; }
      ss += __shfl_xor(ss, 1); ss += __shfl_xor(ss, 2); ss += __shfl_xor(ss, 4);
      const float rstd = rsqrtf(ss * (1.f / 128.f) + EPS);
      const bf16_t* gp = BIG + (size_t)t * 3584 + 1536 + h * 128 + n0;
      const u32x4 g0 = *(const u32x4*)gp, g1 = *(const u32x4*)(gp + 8);
      float gt[16];
      gt[0] = bflo(g0.x); gt[1] = bfhi(g0.x); gt[2] = bflo(g0.y); gt[3] = bfhi(g0.y); gt[4] = bflo(g0.z); gt[5] = bfhi(g0.z); gt[6] = bflo(g0.w); gt[7] = bfhi(g0.w);
      gt[8] = bflo(g1.x); gt[9] = bfhi(g1.x); gt[10] = bflo(g1.y); gt[11] = bfhi(g1.y); gt[12] = bflo(g1.z); gt[13] = bfhi(g1.z); gt[14] = bflo(g1.w); gt[15] = bfhi(g1.w);
#pragma unroll
      for (int e = 0; e < 16; ++e) o[e] = o[e] * rstd * ng[n0 + e] * silu_(gt[e]);
      u32x4 p0, p1;
      p0.x = pk2(o[0], o[1]); p0.y = pk2(o[2], o[3]); p0.z = pk2(o[4], o[5]); p0.w = pk2(o[6], o[7]);
      p1.x = pk2(o[8], o[9]); p1.y = pk2(o[10], o[11]); p1.z = pk2(o[12], o[13]); p1.w = pk2(o[14], o[15]);
      bf16_t* op = OB + (size_t)t * 1024 + h * 128 + n0;
      *(u32x4*)op = p0; *(u32x4*)(op + 8) = p1;
    }
  }
#undef DN_LOAD
  __syncthreads();
}

struct AttnP {
  const bf16_t* Q; const bf16_t* K; int ld;
  const bf16_t* VT;
  const float* qg; const float* kg; const float* CF; const bf16_t* gate;
  bf16_t* O;
  int H;
};
template <bool SBK>
__device__ __forceinline__ void attn_unit(unsigned char* lds, const AttnP& P, int bh, int qb) {
  const int tid = tid_fresh(), lane = tid & 63, wave = tid >> 6, fr = lane & 15, fq = lane >> 4;
  bf16_t* K_s = (bf16_t*)lds; bf16_t* V_s = (bf16_t*)(lds + 34816); float* ck_s = (float*)(lds + 71680);
  const int b = bh / P.H, h = bh - b * P.H; const int tb = b * SEQ;
  const int q = qb * 128 + wave * 16 + fr;
  const int qmax_w = qb * 128 + wave * 16 + 15;
  const int ld = P.ld;
  bf16x8 qf[4];
  {
    const bf16_t* qp = P.Q + (size_t)(tb + q) * ld + h * 128 + fq * 8;
    float v[32]; float ss = 0.f;
#pragma unroll
    for (int kk = 0; kk < 4; ++kk) {
      const u32x4 x = *(const u32x4*)(qp + 32 * kk);
      v[kk * 8 + 0] = bflo(x.x); v[kk * 8 + 1] = bfhi(x.x); v[kk * 8 + 2] = bflo(x.y); v[kk * 8 + 3] = bfhi(x.y);
      v[kk * 8 + 4] = bflo(x.z); v[kk * 8 + 5] = bfhi(x.z); v[kk * 8 + 6] = bflo(x.w); v[kk * 8 + 7] = bfhi(x.w);
    }
    float sc = QSCALE;
    if (!SBK) {
#pragma unroll
      for (int e = 0; e < 32; ++e) ss += v[e] * v[e];
      ss += __shfl_xor(ss, 16); ss += __shfl_xor(ss, 32);
      sc = QSCALE * rsqrtf(ss * (1.f / 128.f) + EPS);
    }
#pragma unroll
    for (int kk = 0; kk < 4; ++kk) {
      float g[8];
#pragma unroll
      for (int e = 0; e < 8; ++e) g[e] = SBK ? 1.f : P.qg[fq * 8 + 32 * kk + e];
      u32x4 w;
      w.x = pk2(v[kk * 8 + 0] * sc * g[0], v[kk * 8 + 1] * sc * g[1]); w.y = pk2(v[kk * 8 + 2] * sc * g[2], v[kk * 8 + 3] * sc * g[3]);
      w.z = pk2(v[kk * 8 + 4] * sc * g[4], v[kk * 8 + 5] * sc * g[5]); w.w = pk2(v[kk * 8 + 6] * sc * g[6], v[kk * 8 + 7] * sc * g[7]);
      qf[kk] = __builtin_bit_cast(bf16x8, w);
    }
  }
  bf16x8 Ue, Uo, U1;
  {
    u32x4 e, o, one;
    const unsigned ONE = 0x3F80u;
    unsigned t[4], z[4];
#pragma unroll
    for (int i = 0; i < 4; ++i) { t[i] = (fq * 4 + i > fr) ? ONE : 0u; z[i] = 0u; }
    e.x = t[0] | (t[1] << 16); e.y = t[2] | (t[3] << 16); e.z = ONE | (ONE << 16); e.w = ONE | (ONE << 16);
    o.x = 0u; o.y = 0u; o.z = t[0] | (t[1] << 16); o.w = t[2] | (t[3] << 16);
    one.x = one.y = one.z = one.w = ONE | (ONE << 16);
    Ue = __builtin_bit_cast(bf16x8, e); Uo = __builtin_bit_cast(bf16x8, o); U1 = __builtin_bit_cast(bf16x8, one);
    (void)z;
  }
  const int nt = 2 * qb + 2;
  f32x4 acc_o[8];
#pragma unroll
  for (int dt = 0; dt < 8; ++dt) acc_o[dt] = (f32x4){0.f, 0.f, 0.f, 0.f};
  float m_run = -INFINITY, l_run = 0.f, R = 0.f;
  const int kr = tid >> 4, kc = (tid & 15) * 8;
  const int vr = tid >> 3, vc = (tid & 7) * 8;
  u32x4 rk[2], rv[2]; float rc = 0.f;
  float kgv[8];
#pragma unroll
  for (int e = 0; e < 8; ++e) kgv[e] = SBK ? 1.f : P.kg[kc + e];
#define AT_LOAD(ti) do { const int k0_ = (ti) * 64; \
    _Pragma("unroll") for (int i = 0; i < 2; ++i) { rk[i] = *(const u32x4*)(P.K + (size_t)(tb + k0_ + kr + 32 * i) * ld + h * 128 + kc); \
      rv[i] = *(const u32x4*)(P.VT + (size_t)(h * 128 + vr + 64 * i) * T + tb + k0_ + vc); } \
    if (!SBK && tid < 64) rc = P.CF[bh * SEQ + k0_ + tid]; } while (0)
#define AT_STORE(buf) do { \
    _Pragma("unroll") for (int i = 0; i < 2; ++i) { u32x4 x = rk[i]; \
      if (!SBK) { float v[8]; v[0] = bflo(x.x); v[1] = bfhi(x.x); v[2] = bflo(x.y); v[3] = bfhi(x.y); v[4] = bflo(x.z); v[5] = bfhi(x.z); v[6] = bflo(x.w); v[7] = bfhi(x.w); \
        float ss = 0.f; _Pragma("unroll") for (int e = 0; e < 8; ++e) ss += v[e] * v[e]; \
        ss += __shfl_xor(ss, 1); ss += __shfl_xor(ss, 2); ss += __shfl_xor(ss, 4); ss += __shfl_xor(ss, 8); \
        const float r = rsqrtf(ss * (1.f / 128.f) + EPS); \
        x.x = pk2(v[0] * r * kgv[0], v[1] * r * kgv[1]); x.y = pk2(v[2] * r * kgv[2], v[3] * r * kgv[3]); x.z = pk2(v[4] * r * kgv[4], v[5] * r * kgv[5]); x.w = pk2(v[6] * r * kgv[6], v[7] * r * kgv[7]); } \
      *(u32x4*)(K_s + (buf) * 8704 + (kr + 32 * i) * 136 + kc) = x; \
      *(u32x4*)(V_s + (buf) * 9216 + (vr + 64 * i) * 72 + vc) = rv[i]; } \
    if (!SBK && tid < 64) ck_s[(buf) * 64 + tid] = rc; } while (0)
  AT_LOAD(SBK ? nt - 1 : 0);
  AT_STORE(0);
  __syncthreads();
  for (int it = 0; it < nt; ++it) {
    const int ti = SBK ? nt - 1 - it : it; const int buf = it & 1; const int k0 = ti * 64;
    if (it + 1 < nt) AT_LOAD(SBK ? nt - 2 - it : it + 1);
    if (k0 <= qmax_w) {
      const bf16_t* Kb = K_s + buf * 8704; const bf16_t* Vb = V_s + buf * 9216;
      f32x4 s[4];
#pragma unroll
      for (int kt = 0; kt < 4; ++kt) {
        s[kt] = (f32x4){0.f, 0.f, 0.f, 0.f};
#pragma unroll
        for (int kk = 0; kk < 4; ++kk) s[kt] = MFMA16(*(const bf16x8*)(Kb + (kt * 16 + fr) * 136 + fq * 8 + 32 * kk), qf[kk], s[kt]);
      }
      bf16x8 pf[2];
      if (!SBK) {
        float mx = -INFINITY;
#pragma unroll
        for (int kt = 0; kt < 4; ++kt) {
          const float4 cv = *(const float4*)(ck_s + buf * 64 + kt * 16 + fq * 4);
          const float cc[4] = {cv.x, cv.y, cv.z, cv.w};
#pragma unroll
          for (int j = 0; j < 4; ++j) { const int key = k0 + kt * 16 + fq * 4 + j; const float v = (key <= q) ? s[kt][j] - cc[j] : -INFINITY; s[kt][j] = v; mx = fmaxf(mx, v); }
        }
        mx = fmaxf(mx, __shfl_xor(mx, 16)); mx = fmaxf(mx, __shfl_xor(mx, 32));
        const float m_new = fmaxf(m_run, mx);
        const float alpha = __expf(m_run - m_new);
        m_run = m_new;
        float ps = 0.f;
#pragma unroll
        for (int kt = 0; kt < 4; ++kt)
#pragma unroll
          for (int j = 0; j < 4; ++j) { const float p = __expf(s[kt][j] - m_new); s[kt][j] = p; ps += p; }
        l_run = l_run * alpha + ps;
#pragma unroll
        for (int dt = 0; dt < 8; ++dt) acc_o[dt] = acc_o[dt] * alpha;
      } else {
        float lsig[4][4];
        bf16x8 lf[2];
#pragma unroll
        for (int kt = 0; kt < 4; ++kt)
#pragma unroll
          for (int j = 0; j < 4; ++j) {
            const int key = k0 + kt * 16 + fq * 4 + j; const float z = s[kt][j]; const float sp = softplus_(z);
            lsig[kt][j] = z - sp; s[kt][j] = (key < q) ? -sp : 0.f;
          }
#pragma unroll
        for (int g = 0; g < 2; ++g) { u32x4 w; w.x = pk2(s[2 * g][0], s[2 * g][1]); w.y = pk2(s[2 * g][2], s[2 * g][3]); w.z = pk2(s[2 * g + 1][0], s[2 * g + 1][1]); w.w = pk2(s[2 * g + 1][2], s[2 * g + 1][3]); lf[g] = __builtin_bit_cast(bf16x8, w); }
        f32x4 tl[4], tot;
        const f32x4 zero4 = {0.f, 0.f, 0.f, 0.f};
        tl[0] = MFMA16(Ue, lf[0], zero4); tl[0] = MFMA16(U1, lf[1], tl[0]);
        tl[1] = MFMA16(Uo, lf[0], zero4); tl[1] = MFMA16(U1, lf[1], tl[1]);
        tl[2] = MFMA16(Ue, lf[1], zero4);
        tl[3] = MFMA16(Uo, lf[1], zero4);
        tot = MFMA16(U1, lf[0], zero4); tot = MFMA16(U1, lf[1], tot);
#pragma unroll
        for (int kt = 0; kt < 4; ++kt)
#pragma unroll
          for (int j = 0; j < 4; ++j) { const int key = k0 + kt * 16 + fq * 4 + j; s[kt][j] = (key < q) ? __expf(lsig[kt][j] + tl[kt][j] + R) : 0.f; }
        R += tot[0];
      }
#pragma unroll
      for (int g = 0; g < 2; ++g) { u32x4 w; w.x = pk2(s[2 * g][0], s[2 * g][1]); w.y = pk2(s[2 * g][2], s[2 * g][3]); w.z = pk2(s[2 * g + 1][0], s[2 * g + 1][1]); w.w = pk2(s[2 * g + 1][2], s[2 * g + 1][3]); pf[g] = __builtin_bit_cast(bf16x8, w); }
#pragma unroll
      for (int dt = 0; dt < 8; ++dt)
#pragma unroll
        for (int g = 0; g < 2; ++g) {
          const bf16_t* vp = Vb + (dt * 16 + fr) * 72 + 32 * g + fq * 4;
          u32x4 a; const u32x2 a0 = *(const u32x2*)vp, a1 = *(const u32x2*)(vp + 16);
          a.x = a0.x; a.y = a0.y; a.z = a1.x; a.w = a1.y;
          acc_o[dt] = MFMA16(__builtin_bit_cast(bf16x8, a), pf[g], acc_o[dt]);
        }
    }
    if (it + 1 < nt) AT_STORE(buf ^ 1);
    __syncthreads();
  }
#undef AT_LOAD
#undef AT_STORE
  {
    float inv = 1.f;
    if (!SBK) { float l = l_run; l += __shfl_xor(l, 16); l += __shfl_xor(l, 32); inv = 1.f / l; }
    bf16_t* op = P.O + (size_t)(tb + q) * 1024 + h * 128 + fq * 4;
#pragma unroll
    for (int dt = 0; dt < 8; ++dt) {
      float o0 = acc_o[dt][0] * inv, o1 = acc_o[dt][1] * inv, o2 = acc_o[dt][2] * inv, o3 = acc_o[dt][3] * inv;
      if (!SBK) {
        const u32x2 gv = *(const u32x2*)(P.gate + (size_t)(tb + q) * ld + h * 128 + dt * 16 + fq * 4);
        o0 *= sigmoid_(bflo(gv.x)); o1 *= sigmoid_(bfhi(gv.x)); o2 *= sigmoid_(bflo(gv.y)); o3 *= sigmoid_(bfhi(gv.y));
      }
      u32x2 p; p.x = pk2(o0, o1); p.y = pk2(o2, o3);
      *(u32x2*)(op + dt * 16) = p;
    }
  }
}

struct Args { const float* in[19]; float* out; unsigned char* ws; };

typedef const __attribute__((address_space(4))) Args* ArgsP;
__device__ __forceinline__ ArgsP fresh_args();

__device__ __forceinline__ ArgsP fresh_args() { auto p = __builtin_amdgcn_kernarg_segment_ptr(); asm volatile("" : "+s"(p)); return (ArgsP)p; }
#define WSP(T_, off) ((T_*)(ws + (off)))

#ifdef DEBUG_NAN
__device__ __forceinline__ void chk_words(const unsigned* p, size_t nwords, bool bf, unsigned* err, unsigned code) {
  bool bad = false, nan = false;
  for (size_t i = ((size_t)blockIdx.x * 512 + threadIdx.x); i < nwords; i += (size_t)gridDim.x * 512) {
    const unsigned w = p[i];
    if ((w & 0x7F800000u) >= (141u << 23)) bad = true;
    if ((w & 0x7F800000u) == 0x7F800000u) nan = true;
    if (bf && (w & 0x7F80u) >= (141u << 7)) bad = true;
    if (bf && (w & 0x7F80u) == 0x7F80u) nan = true;
  }
  if (bad) atomicCAS(err, 0u, code);
  if (nan) atomicCAS(err + 1, 0u, code);
}
#endif

__global__ void __launch_bounds__(512, 2) fwd_megakernel(Args a_unused) {
  extern __shared__ __attribute__((aligned(16))) unsigned char lds[];
  cg::grid_group grid = cg::this_grid();
  PG8_LAS unsigned char* glds = (PG8_LAS unsigned char*)lds;
  const int G = gridDim.x, bid = blockIdx.x;

  for (int step = 0; step < 8; ++step) {
    const int l = step >> 1, which = step & 1, j = l >> 1; const bool even = (l & 1) == 0;
    const int np = which ? 3 : 9;
    const int nmain = even ? 3584 : 2048, nv = even ? 512 : 1024;
    for (int p = 0; p < np; ++p) {
      if (p == 6 && !even) continue;
      if (p == 1 || p == 2 || p == 4 || p == 5 || p == 8) {
        ArgsP a = fresh_args(); unsigned char* ws = a->ws;
        pg8::Gemm g; EpiAny E; int oid = bid;
        if (p == 1) { g.A = WSP(bf16_t, WS_XN); g.Bt = which ? WSP(bf16_t, WS_GU2) : WSP(bf16_t, WS_GU1); g.M = T; g.N = 5632; g.K = 1024; E.mode = 0; E.P = WSP(void, WS_BIG); E.ldc = FF; E.scale = 0.f; }
        else if (p == 2) { g.A = WSP(bf16_t, WS_BIG); g.Bt = which ? WSP(bf16_t, WS_DN2) : WSP(bf16_t, WS_DN1); g.M = T; g.N = 1024; g.K = FF; E.mode = 1; E.P = a->out; E.ldc = 1024; E.scale = 0.5f; }
        else if (p == 4) { g.A = WSP(bf16_t, WS_XN); g.Bt = WSP(bf16_t, WS_WIN); g.M = T; g.N = nmain; g.K = 1024; E.mode = 2; E.P = WSP(void, WS_BIG); E.ldc = nmain; E.scale = 0.f;
                           if (even) cumsum_logf(lds, WSP(float, WS_SM), WSP(float, WS_CF)); }
        else if (p == 5) { g.A = WSP(bf16_t, WS_WIN) + (size_t)nmain * 1024; g.Bt = WSP(bf16_t, WS_XN); g.M = nv; g.N = T; g.K = 1024; E.mode = 2; E.P = WSP(void, WS_VT); E.ldc = T; E.scale = 0.f; if (even) oid = (bid + G / 2) % G; }
        else { g.A = WSP(bf16_t, WS_OB); g.Bt = WSP(bf16_t, WS_WOUT); g.M = T; g.N = 1024; g.K = 1024; E.mode = 1; E.P = a->out; E.ldc = 1024; E.scale = 1.0f; }
        pg8::StaticOrder S; S.init(g.M, g.N, G, oid);
#ifndef NO_G
        pg8::gemm_phase<EpiAny, pg8::StaticOrder>(glds, g, S, E, nullptr);
#endif
        if (p == 4) continue;
      } else if (p == 0) {
        ArgsP a = fresh_args(); unsigned char* ws = a->ws; float* X = a->out;
        if (which == 0) {
          int rot = 0; float* sT = (float*)lds;
          const float* gu1 = a->in[2] + (size_t)l * 1024 * 5632; const float* dn1 = a->in[3] + (size_t)l * 2816 * 1024;
          const float* gu2 = a->in[17] + (size_t)l * 1024 * 5632; const float* dn2 = a->in[18] + (size_t)l * 2816 * 1024;
          transpose_job(sT, gu1, 5632, 1024, 2816, WSP(bf16_t, WS_GU1), 256, 0, rot);
          transpose_job(sT, gu1 + 2816, 5632, 1024, 2816, WSP(bf16_t, WS_GU1), 256, 128, rot);
          transpose_job(sT, dn1, 1024, 2816, 1024, WSP(bf16_t, WS_DN1), 128, 0, rot);
          transpose_job(sT, gu2, 5632, 1024, 2816, WSP(bf16_t, WS_GU2), 256, 0, rot);
          transpose_job(sT, gu2 + 2816, 5632, 1024, 2816, WSP(bf16_t, WS_GU2), 256, 128, rot);
          transpose_job(sT, dn2, 1024, 2816, 1024, WSP(bf16_t, WS_DN2), 128, 0, rot);
          if (even) {
            const float* wi = a->in[5] + (size_t)j * 1024 * 4108;
            transpose_job(sT, wi, 4108, 1024, 2048, WSP(bf16_t, WS_WIN), 128, 0, rot);
            transpose_job(sT, wi + 2056, 4108, 1024, 1024, WSP(bf16_t, WS_WIN), 128, 2048, rot);
            transpose_job(sT, wi + 3592, 4108, 1024, 512, WSP(bf16_t, WS_WIN), 128, 3072, rot);
            transpose_job(sT, wi + 3080, 4108, 1024, 512, WSP(bf16_t, WS_WIN), 128, 3584, rot);
            transpose_job(sT, a->in[13] + (size_t)j * 1024 * 1024, 1024, 1024, 1024, WSP(bf16_t, WS_WOUT), 128, 0, rot);
          } else {
            transpose_job(sT, a->in[14] + (size_t)j * 1024 * 3072, 3072, 1024, 3072, WSP(bf16_t, WS_WIN), 128, 0, rot);
            transpose_job(sT, a->in[15] + (size_t)j * 1024 * 1024, 1024, 1024, 1024, WSP(bf16_t, WS_WOUT), 128, 0, rot);
          }
        }
        const float* gain = (which ? a->in[16] : a->in[1]) + l * 1024;
        const bool first = (step == 0);
        norm_phase<false>(lds, first ? a->in[0] : X, first ? X : nullptr, gain, WSP(bf16_t, WS_XN), nullptr, nullptr, nullptr, nullptr, nullptr);
      } else if (p == 3) {
        ArgsP a = fresh_args(); unsigned char* ws = a->ws;
        if (even) norm_phase<true>(lds, a->out, nullptr, a->in[4] + l * 1024, WSP(bf16_t, WS_XN), a->in[5] + (size_t)j * 1024 * 4108, a->in[7] + j * 4, a->in[8] + j * 4, a->in[12] + j * 4, WSP(float, WS_SM));
        else norm_phase<false>(lds, a->out, nullptr, a->in[4] + l * 1024, WSP(bf16_t, WS_XN), nullptr, nullptr, nullptr, nullptr, nullptr);
      } else if (p == 6) {
#ifndef NO_PREP
        ArgsP a = fresh_args(); unsigned char* ws = a->ws;
        for (int u = bid; u < 1024; u += G) dn_prep_unit(lds, u, WSP(bf16_t, WS_BIG), WSP(float, WS_SM), a->in[6] + (size_t)j * 4 * 1536, ws + WS_DNX, WSP(float, WS_GL));
#endif
      } else if (p == 7) {
        if (even) {
#ifndef NO_SCAN
          if (bid < 16) { ArgsP a = fresh_args(); unsigned char* ws = a->ws; dn_scan(lds, bid, ws + WS_DNX, WSP(float, WS_GL), WSP(bf16_t, WS_BIG), a->in[9] + j * 128, WSP(bf16_t, WS_OB)); }
#endif
          ArgsP a = fresh_args(); unsigned char* ws = a->ws;
          int* qslot = (int*)(lds + 150 * 1024);
          AttnP P; P.Q = WSP(bf16_t, WS_BIG) + 2048; P.K = WSP(bf16_t, WS_BIG) + 2560; P.ld = 3584; P.VT = WSP(bf16_t, WS_VT); P.qg = a->in[10] + j * 128; P.kg = a->in[11] + j * 128;
          P.CF = WSP(float, WS_CF); P.gate = WSP(bf16_t, WS_BIG) + 3072; P.O = WSP(bf16_t, WS_OB) + 512; P.H = 4;
          unsigned* ctr = WSP(unsigned, WS_CTL) + l;
          for (;;) {
            if (threadIdx.x == 0) *qslot = (int)atomicAdd(ctr, 1u);
            __syncthreads();
            const int unit = *qslot;
            __syncthreads();
            if (unit >= 512) break;
#ifndef NO_FOX
            attn_unit<false>(lds, P, unit & 15, 31 - (unit >> 4));
#endif
          }
        } else {
          ArgsP a = fresh_args(); unsigned char* ws = a->ws;
          int* qslot = (int*)(lds + 150 * 1024);
          AttnP P; P.Q = WSP(bf16_t, WS_BIG); P.K = WSP(bf16_t, WS_BIG) + 1024; P.ld = 2048; P.VT = WSP(bf16_t, WS_VT); P.qg = nullptr; P.kg = nullptr; P.CF = nullptr; P.gate = nullptr; P.O = WSP(bf16_t, WS_OB); P.H = 8;
          unsigned* ctr = WSP(unsigned, WS_CTL) + l;
          for (;;) {
            if (threadIdx.x == 0) *qslot = (int)atomicAdd(ctr, 1u);
            __syncthreads();
            const int unit = *qslot;
            __syncthreads();
            if (unit >= 1024) break;
#ifndef NO_SB
            attn_unit<true>(lds, P, unit & 31, 31 - (unit >> 5));
#endif
          }
        }
      }
      grid.sync();
#ifdef DEBUG_NAN
      {
        ArgsP a = fresh_args(); unsigned* err = (unsigned*)(a->ws + WS_CTL) + 64; const unsigned code = (unsigned)(step * 10 + p + 1);
        const unsigned* cp = nullptr; size_t nw = 0; bool bf = true;
        if (p == 0 || p == 3) { cp = (const unsigned*)(a->ws + WS_XN); nw = (size_t)T * 512; }
        if (p == 1) { cp = (const unsigned*)(a->ws + WS_BIG); nw = (size_t)T * FF / 2; }
        if (p == 2 || p == 8) { cp = (const unsigned*)a->out; nw = (size_t)T * 1024; bf = false; }
        if (p == 5) { cp = (const unsigned*)(a->ws + WS_BIG); nw = (size_t)T * nmain / 2; }
        if (p == 6) { cp = (const unsigned*)(a->ws + WS_DNX); nw = (size_t)1024 * DNX_UNIT / 4; }
        if (p == 7) { cp = (const unsigned*)(a->ws + WS_OB); nw = (size_t)T * 512; }
        chk_words(cp, nw, bf, err, code);
        if (p == 5) chk_words((const unsigned*)(a->ws + WS_VT), (size_t)T * nv / 2, true, err, 90u + (unsigned)step);
      }
#endif
    }
  }
#ifdef DEBUG_NAN
  {
    ArgsP a = fresh_args(); float* X = a->out; const unsigned err = *((volatile unsigned*)(a->ws + WS_CTL) + 64), errn = *((volatile unsigned*)(a->ws + WS_CTL) + 65);
    for (size_t i = ((size_t)blockIdx.x * 512 + threadIdx.x); i < (size_t)T * 1024; i += (size_t)gridDim.x * 512) {
      X[i] = (i == 5 && (err | errn)) ? (errn ? 100.f * (float)errn : (float)err) : 0.f;
    }
  }
#endif
}

extern "C" void kernel_launch(void* const* d_in, const int* in_sizes, int n_in,
                              void* d_out, int out_size, void* d_ws, size_t ws_size,
                              hipStream_t stream) {
  static int grid = 0;
  if (grid == 0) {
    int dev = 0, cus = 0, per_cu = 0;
    (void)hipGetDevice(&dev);
    (void)hipDeviceGetAttribute(&cus, hipDeviceAttributeMultiprocessorCount, dev);
    (void)hipFuncSetAttribute((const void*)fwd_megakernel, hipFuncAttributeMaxDynamicSharedMemorySize, LDS_BYTES);
    (void)hipOccupancyMaxActiveBlocksPerMultiprocessor(&per_cu, (const void*)fwd_megakernel, 512, LDS_BYTES);
    (void)hipGetLastError();
    grid = cus > 0 ? cus : 256;
    if (ws_size < WS_END || n_in != 19) { fprintf(stderr, "kernel_launch: ws %zu < %zu or n_in %d\n", ws_size, (size_t)WS_END, n_in); grid = -1; }
    fprintf(stderr, "kernel_launch: cus %d per_cu %d grid %d ws %zu need %zu\n", cus, per_cu, grid, ws_size, (size_t)WS_END);
  }
  if (grid < 0) return;
  (void)hipMemsetAsync((char*)d_ws + WS_CTL, 0, 4096, stream);
  Args a{};
  for (int i = 0; i < 19; ++i) a.in[i] = (const float*)d_in[i];
  a.out = (float*)d_out; a.ws = (unsigned char*)d_ws;
  void* args[] = {&a};
  hipError_t e = hipLaunchCooperativeKernel((const void*)fwd_megakernel, dim3(grid), dim3(512), args, LDS_BYTES, stream);
  if (e != hipSuccess) fprintf(stderr, "cooperative launch failed: %s (grid %d)\n", hipGetErrorString(e), grid);
}
```

```cpp
#include <hip/hip_runtime.h>
#include <hip/hip_cooperative_groups.h>
#include <cstdio>
namespace cg = cooperative_groups;
__device__ __forceinline__ int tid_fresh() { int t = threadIdx.x; asm volatile("" : "+v"(t)); return t; }
namespace pg8 {
#define PG8_LAS __attribute__((address_space(3)))
typedef unsigned short bf16_t;
typedef short bf16x8 __attribute__((ext_vector_type(8)));
typedef float f32x4 __attribute__((ext_vector_type(4)));
typedef unsigned u32x4 __attribute__((ext_vector_type(4)));
constexpr int BM = 256, BK = 64, HALF = 128, HTB = HALF * BK * 2  , STAGE_BYTES = 8 * HTB, NXCD = 8, WGM = 8;

__host__ __device__ __forceinline__ int lds_byte(int r, int c) { const int st = (r >> 4) * 2 + (c >> 5), rr = r & 15, cc = c & 31, ob = rr * 64 + cc * 2; return st * 1024 + (ob ^ (((ob >> 9) & 1) << 5)); }
__host__ __device__ __forceinline__ void stage_rc(int b, int& R, int& C) { const int st = b / 1024, sb = b % 1024, swz = sb ^ (((sb >> 9) & 1) << 5); R = (st >> 1) * 16 + swz / 64; C = (st & 1) * 32 + (swz % 64) / 2; }
__host__ __device__ __forceinline__ int perm32(int rho) { const int n = rho >> 4, i = rho & 15; return 8 * (i >> 2) + 4 * n + (i & 3); }

struct Unit { int pm, pn; };
struct Gemm { const bf16_t* A; const bf16_t* Bt; int M, N, K; };

struct StaticOrder {
    int nM, nN, nwg, G, c;
    __host__ __device__ void init(int M, int N, int G_, int c_) { nM = M / BM; nN = N / BM; nwg = nM * nN; G = G_; c = c_; }
    __host__ __device__ bool next(int i, Unit& u) const {
        const long L = (long)i * G + c; if (L >= nwg) return false;
        int wgid = (int)L; { const int q = nwg / NXCD, r = nwg % NXCD, xcd = wgid % NXCD, off = wgid / NXCD; wgid = (xcd < r ? xcd * (q + 1) : r * (q + 1) + (xcd - r) * q) + off; }
        const int nig = WGM * nN, gid = wgid / nig, fm = gid * WGM, gsz = (nM - fm) < WGM ? (nM - fm) : WGM;
        u.pm = fm + ((wgid % nig) % gsz); u.pn = (wgid % nig) / gsz; return true;
    }
    __device__ __forceinline__ void a_ready(const Unit&) const {}
    __device__ __forceinline__ void done(const Unit&) const {}
};
struct CountedOrder : StaticOrder {
    const unsigned* ready; unsigned need; unsigned* tmo;
    __device__ __forceinline__ void a_ready(const Unit& u) const {
        if (threadIdx.x < 64) {
            const unsigned long long t0 = __builtin_amdgcn_s_memrealtime(); unsigned polls = 0;
            while ((unsigned)__builtin_amdgcn_readfirstlane(__hip_atomic_load(ready + 64 * u.pm, __ATOMIC_RELAXED, __HIP_MEMORY_SCOPE_AGENT)) < need) {
                if ((++polls & 255u) == 0u && __builtin_amdgcn_readfirstlane(__hip_atomic_load(tmo, __ATOMIC_RELAXED, __HIP_MEMORY_SCOPE_AGENT)) != 0u) break;
                if (__builtin_amdgcn_s_memrealtime() - t0 > 2000000ull) {
                    if (threadIdx.x == 0) { unsigned expect = 0u; __hip_atomic_compare_exchange_strong(tmo + 1, &expect, 0x600u | (unsigned)(u.pm & 0xff), __ATOMIC_RELAXED, __ATOMIC_RELAXED, __HIP_MEMORY_SCOPE_AGENT); __hip_atomic_store(tmo, 1u, __ATOMIC_RELAXED, __HIP_MEMORY_SCOPE_AGENT); }
                    break; }
                __builtin_amdgcn_s_sleep(2); }
            __builtin_amdgcn_fence(__ATOMIC_ACQUIRE, "agent");
            asm volatile("s_waitcnt vmcnt(0)" ::: "memory");
        }
#if !defined(BROKEN_HOOK_NO_BARRIER)
        asm volatile("" ::: "memory"); __builtin_amdgcn_s_barrier(); asm volatile("" ::: "memory");
#endif
    }
};

__device__ __forceinline__ unsigned cvt_pk_bf16(float lo, float hi) { unsigned r; asm volatile("v_cvt_pk_bf16_f32 %0, %1, %2" : "=v"(r) : "v"(lo), "v"(hi)); return r; }

template <class Epi, class Sched, bool STAMP = false>
__device__ __forceinline__ void gemm_phase(PG8_LAS unsigned char* lds, const Gemm g, const Sched& S, const Epi& E, unsigned long long* stamps) {
    const int tid = tid_fresh(), wid = __builtin_amdgcn_readfirstlane(tid >> 6), lane = tid & 63, wr = wid >> 2, wc = wid & 3, fr = lane & 15, fq = lane >> 4;
    const int K = g.K, nt = K / BK;
    int ts_lo = 0, ts_hi = 0, nts = 0; const unsigned long long rt_entry = STAMP ? (unsigned long long)wall_clock64() : 0ull;
#define PG8_STAMP() do { if (STAMP && wid == 0 && nts < 64) { const unsigned long long _c = (unsigned long long)clock64(); \
        ts_lo = (lane == nts) ? (int)(unsigned)_c : ts_lo; ts_hi = (lane == nts) ? (int)(unsigned)(_c >> 32) : ts_hi; ++nts; } } while (0)
    PG8_STAMP();
    unsigned voffA[2], voffB[2];
#pragma unroll
    for (int i = 0; i < 2; ++i) { int R, C; stage_rc(tid * 16 + i * 8192, R, C); const int Rb = E.perm() ? ((R & ~31) + perm32(R & 31)) : R;
        voffA[i] = (unsigned)(R * K + C) * 2u; voffB[i] = (unsigned)(Rb * K + C) * 2u; }
    const size_t kstep = (size_t)(BK * 2);
    const size_t hstep = (size_t)HALF * K * 2;
    const size_t tstep = 2 * hstep;
    const unsigned ldsw = (unsigned)wid * 1024u;
    const int aoff = lds_byte(wr * 64 + fr, fq * 8), boff = lds_byte(wc * 32 + fr, fq * 8);
#define PG8_SA(b, h) (((b) * 2 + (h)) * HTB)
#define PG8_SB(b, h) ((4 + (b) * 2 + (h)) * HTB)
#define PG8_STAGE(bufoff, gbase, voff) do { _Pragma("unroll") for (int _i = 0; _i < 2; ++_i) \
        __builtin_amdgcn_global_load_lds((const unsigned*)((const char*)(gbase) + (voff)[_i]), (PG8_LAS unsigned*)(lds + (bufoff) + ldsw + _i * 8192), 16, 0, 0); } while (0)
#define PG8_LDA(dst, b, h) do { _Pragma("unroll") for (int m = 0; m < 4; ++m) _Pragma("unroll") for (int k = 0; k < 2; ++k) dst[m][k] = *(const PG8_LAS bf16x8*)(lds + PG8_SA(b, h) + aoff + m * 2048 + k * 1024); } while (0)
#define PG8_LDB(dst, b, h) do { _Pragma("unroll") for (int n = 0; n < 2; ++n) _Pragma("unroll") for (int k = 0; k < 2; ++k) dst[n][k] = *(const PG8_LAS bf16x8*)(lds + PG8_SB(b, h) + boff + n * 2048 + k * 1024); } while (0)
#define PG8_MMA(ai, bj, At, Bt) do { __builtin_amdgcn_s_setprio(1); _Pragma("unroll") for (int m = 0; m < 4; ++m) _Pragma("unroll") for (int n = 0; n < 2; ++n) _Pragma("unroll") for (int k = 0; k < 2; ++k) \
        acc[ai][bj][m][n] = __builtin_amdgcn_mfma_f32_16x16x32_bf16(Bt[n][k], At[m][k], acc[ai][bj][m][n], 0, 0, 0); __builtin_amdgcn_s_setprio(0); } while (0)
#define PG8_WAIT_V(n) asm volatile("s_waitcnt vmcnt(" #n ")" ::: "memory")
#define PG8_WAIT_L(n) asm volatile("s_waitcnt lgkmcnt(" #n ")" ::: "memory")
#define PG8_BAR __builtin_amdgcn_s_barrier()
#define PG8_SCHED __builtin_amdgcn_sched_barrier(0)
    Unit cur, nxt; int ui = 0;
    if (!S.next(0, cur)) return;
    f32x4 acc[2][2][4][2];
    E.init(acc, cur, wr, wc, fr, fq);
    bf16x8 At[4][2], B0[2][2], B1[2][2];
    const char* cA = (const char*)g.A + (size_t)cur.pm * tstep; const char* cB = (const char*)g.Bt + (size_t)cur.pn * tstep;
    S.a_ready(cur);
    PG8_STAGE(PG8_SB(0, 0), cB, voffB); PG8_STAGE(PG8_SA(0, 0), cA, voffA); PG8_STAGE(PG8_SB(0, 1), cB + hstep, voffB); PG8_STAGE(PG8_SA(0, 1), cA + hstep, voffA);
    E.prepare(S, tid);
    if (wr == 1) PG8_BAR;
    PG8_WAIT_V(4); PG8_BAR;
    PG8_STAGE(PG8_SB(1, 0), cB + kstep, voffB); PG8_STAGE(PG8_SA(1, 0), cA + kstep, voffA); PG8_STAGE(PG8_SB(1, 1), cB + hstep + kstep, voffB);
    PG8_WAIT_V(6); PG8_BAR;
    PG8_STAMP();
    for (;;) {
        const bool has_next = S.next(ui + 1, nxt);
        const char* nA = has_next ? (const char*)g.A + (size_t)nxt.pm * tstep : cA; const char* nB = has_next ? (const char*)g.Bt + (size_t)nxt.pn * tstep : cB;
        for (int t = 0; t < nt; t += 2) {
            const bool last = (t == nt - 2);
            const char* a1 = cA + (size_t)(t + 1) * kstep;
            const char* a2 = last ? nA : cA + (size_t)(t + 2) * kstep; const char* b2 = last ? nB : cB + (size_t)(t + 2) * kstep;
            const char* a3 = a2 + kstep; const char* b3 = b2 + kstep;
            if (last && has_next) S.a_ready(nxt);
            PG8_LDB(B0, 0, 0); PG8_SCHED; PG8_LDA(At, 0, 0); PG8_STAGE(PG8_SA(1, 1), a1 + hstep, voffA);
            PG8_WAIT_L(8); PG8_BAR; PG8_WAIT_L(0); PG8_MMA(0, 0, At, B0); PG8_BAR; PG8_SCHED;
            PG8_LDB(B1, 0, 1); PG8_STAGE(PG8_SB(0, 0), b2, voffB);
            PG8_BAR; PG8_WAIT_L(0); PG8_MMA(0, 1, At, B1); PG8_BAR;
            PG8_LDA(At, 0, 1); PG8_STAGE(PG8_SA(0, 0), a2, voffA);
            PG8_BAR; PG8_WAIT_L(0); PG8_MMA(1, 0, At, B0); PG8_BAR; PG8_SCHED;
            PG8_STAGE(PG8_SB(0, 1), b2 + hstep, voffB);
            PG8_WAIT_V(6); PG8_BAR; PG8_MMA(1, 1, At, B1); PG8_BAR;
            PG8_LDB(B0, 1, 0); PG8_SCHED; PG8_LDA(At, 1, 0); PG8_STAGE(PG8_SA(0, 1), a2 + hstep, voffA);
            PG8_WAIT_L(8); PG8_BAR; PG8_WAIT_L(0); PG8_MMA(0, 0, At, B0); PG8_BAR; PG8_SCHED;
            PG8_LDB(B1, 1, 1); PG8_STAGE(PG8_SB(1, 0), b3, voffB);
            PG8_BAR; PG8_WAIT_L(0); PG8_MMA(0, 1, At, B1); PG8_BAR;
            PG8_LDA(At, 1, 1); PG8_STAGE(PG8_SA(1, 0), a3, voffA);
            PG8_BAR; PG8_WAIT_L(0); PG8_MMA(1, 0, At, B0); PG8_BAR; PG8_SCHED;
            PG8_STAGE(PG8_SB(1, 1), b3 + hstep, voffB);
            PG8_WAIT_V(6); PG8_BAR; PG8_MMA(1, 1, At, B1); PG8_BAR;
        }
        PG8_STAMP();
        if constexpr (!Epi::AFTER_DRAIN) { E(acc, cur, wr, wc, fr, fq, ui);
#ifdef NREP_E
            if (E.perm()) E(acc, cur, wr, wc, fr, fq, ui);
#endif
            S.done(cur); }
        PG8_STAMP();
        if (!has_next) break;
        E.init(acc, nxt, wr, wc, fr, fq);
        cur = nxt; cA = nA; cB = nB; ++ui;
    }
    PG8_WAIT_V(0);
    if (wr == 0) PG8_BAR;
    PG8_BAR;
    if constexpr (Epi::AFTER_DRAIN) { E.fused(acc, cur, wr, wc, fr, fq, lds, wid, lane); S.done(cur); }
    PG8_STAMP();
    if (STAMP && wid == 0) { stamps[lane] = lane < nts ? (((unsigned long long)(unsigned)ts_hi << 32) | (unsigned)ts_lo) : 0ull;
        if (lane == 62) stamps[62] = rt_entry; if (lane == 63) stamps[63] = (unsigned long long)wall_clock64(); }
#undef PG8_STAMP
#undef PG8_SA
#undef PG8_SB
#undef PG8_STAGE
#undef PG8_LDA
#undef PG8_LDB
#undef PG8_MMA
#undef PG8_WAIT_V
#undef PG8_WAIT_L
#undef PG8_BAR
#undef PG8_SCHED
}
}
#define XB_TMO      128
#define XB_XCNT(j)  (256  + 64 * (j))
#define XB_XSUB(j)  (1280 + 64 * (j))
#define XB_XGEN(j)  (2304 + 64 * (j))
#define XB_TOP      3328
#define XB_TOPGEN   3392
#define XCD_BAR_WORDS 3456
#define XB_SPIN_CAP (1u << 18)
#ifndef LAS
#define LAS __attribute__((address_space(3)))
#endif

__device__ __forceinline__ unsigned xb_ld(unsigned* p)              { return __hip_atomic_load(p, __ATOMIC_RELAXED, __HIP_MEMORY_SCOPE_AGENT); }
__device__ __forceinline__ unsigned xb_add(unsigned* p, unsigned v) { return __hip_atomic_fetch_add(p, v, __ATOMIC_RELAXED, __HIP_MEMORY_SCOPE_AGENT); }
__device__ __forceinline__ unsigned xb_xcc_id() { return (unsigned)__builtin_amdgcn_s_getreg((3 << 11) | 20) & 0xFu; }
#define XB_SPIN(cond, bar) do { unsigned _sp = 0; while (cond) { __builtin_amdgcn_s_sleep(1); \
    if ((++_sp & 255u) == 0u) { if (xb_ld(&(bar)[XB_TMO])) break; if (_sp > XB_SPIN_CAP) { atomicAdd(&(bar)[XB_TMO], 1u); break; } } } } while (0)

struct XcdBarrier {
    unsigned* bar; unsigned x;
    volatile LAS unsigned* st;
};

__device__ __forceinline__ XcdBarrier xcd_barrier_post(unsigned* bar, volatile LAS unsigned* st) {
    XcdBarrier b; b.bar = bar; b.x = xb_xcc_id(); b.st = st;
    if (threadIdx.x == 0) (void)xb_add(&bar[XB_XCNT(b.x)], 1u);
    return b;
}
__device__ __forceinline__ void xcd_barrier_complete(unsigned* bar, unsigned x, unsigned& nloc, unsigned& nx) {
    const unsigned G = gridDim.x * gridDim.y * gridDim.z;
    unsigned sum, cnt, mine, sp = 0u;
    for (;;) {
        sum = 0u; cnt = 0u; mine = 0u;
#pragma unroll
        for (unsigned j = 0; j < 16; ++j) { const unsigned c = xb_ld(&bar[XB_XCNT(j)]); sum += c; cnt += (c > 0u) ? 1u : 0u; mine = (j == x) ? c : mine; }
        if (sum == G) break;
        __builtin_amdgcn_s_sleep(1);
        if ((++sp & 255u) == 0u) { if (xb_ld(&bar[XB_TMO])) break; if (sp > XB_SPIN_CAP) { atomicAdd(&bar[XB_TMO], 1u); break; } }
    }
    nloc = mine > 0u ? mine : 1u; nx = cnt > 0u ? cnt : 1u;
}

__device__ __forceinline__ void xcd_barrier(const XcdBarrier& b) {
    asm volatile("s_waitcnt vmcnt(0)" ::: "memory");
    __syncthreads();
    if (threadIdx.x == 0) {
        unsigned* bar = b.bar;
        __builtin_amdgcn_s_waitcnt(0);
        unsigned nloc = b.st[0], nx = b.st[1];
        if (nloc == 0u) { xcd_barrier_complete(bar, b.x, nloc, nx); b.st[0] = nloc; b.st[1] = nx; }
        const unsigned old = xb_add(&bar[XB_XSUB(b.x)], 1u);
        const unsigned gen = old / nloc;
        if (old + 1u == (gen + 1u) * nloc) {
            __builtin_amdgcn_fence(__ATOMIC_RELEASE, "agent");
            asm volatile("s_waitcnt vmcnt(0)" ::: "memory");
            const unsigned og = xb_add(&bar[XB_TOP], 1u);
            const unsigned tg = og / nx;
            if (og + 1u == (tg + 1u) * nx) xb_add(&bar[XB_TOPGEN], 1u);
            else XB_SPIN(xb_ld(&bar[XB_TOPGEN]) == tg, bar);
            __builtin_amdgcn_fence(__ATOMIC_ACQUIRE, "agent");
            xb_add(&bar[XB_XGEN(b.x)], 1u);
            asm volatile("s_waitcnt vmcnt(0)" ::: "memory");
        } else {
            XB_SPIN(xb_ld(&bar[XB_XGEN(b.x)]) == gen, bar);
            __builtin_amdgcn_fence(__ATOMIC_ACQUIRE, "agent");
            asm volatile("s_waitcnt vmcnt(0)" ::: "memory");
        }
    }
    __syncthreads();
}


using pg8::bf16_t; using pg8::bf16x8; using pg8::f32x4; using pg8::u32x4;
typedef unsigned u32x2 __attribute__((ext_vector_type(2)));

constexpr int T = 16384, DM = 1024, FF = 2816, SEQ = 4096;
constexpr float EPS = 1e-6f;
constexpr float QSCALE = 0.08838834764831845f;

constexpr size_t SZ_GU = (size_t)5632 * 1024 * 2, SZ_DN = (size_t)1024 * 2816 * 2;
constexpr size_t WS_CTL = 0;
constexpr size_t WS_BAR = 4096;
constexpr size_t CTL_BYTES = 32768;
constexpr size_t WS_GU1 = CTL_BYTES;
constexpr size_t WS_DN1 = WS_GU1 + SZ_GU;
constexpr size_t WS_GU2 = WS_DN1 + SZ_DN;
constexpr size_t WS_DN2 = WS_GU2 + SZ_GU;
constexpr size_t WS_WIN = WS_DN2 + SZ_DN;
constexpr size_t WS_WOUT = WS_WIN + (size_t)4096 * 1024 * 2;
constexpr size_t WS_XN = WS_WOUT + (size_t)1024 * 1024 * 2;
constexpr size_t WS_BIG = WS_XN + (size_t)T * 1024 * 2;
constexpr size_t WS_VT = WS_BIG + (size_t)T * 3584 * 2;
constexpr size_t WS_OB = WS_VT + (size_t)1024 * T * 2;
constexpr size_t WS_SM = WS_OB + (size_t)T * 1024 * 2;
constexpr size_t WS_CF = WS_SM + (size_t)T * 16 * 4;
constexpr size_t WS_GL = WS_CF + (size_t)16 * 4096 * 4;
constexpr size_t WS_DNX = WS_GL + 4096;
constexpr size_t DNX_UNIT = 73728;
constexpr size_t WS_OF = WS_DNX + 1024 * DNX_UNIT;
constexpr size_t WS_PSD = WS_OF + (size_t)T * 512 * 4;
constexpr size_t WS_PS = WS_PSD + (size_t)T * 16 * 4;
constexpr size_t WS_END = WS_PS + (size_t)T * 16 * 4;
constexpr int LDS_BYTES = 152 * 1024;
constexpr int RS_TAB_OFF = 128 * 1024;

__device__ __forceinline__ float bf2f(unsigned short b) { return __uint_as_float(((unsigned)b) << 16); }
__device__ __forceinline__ float bflo(unsigned w) { return __uint_as_float(w << 16); }
__device__ __forceinline__ float bfhi(unsigned w) { return __uint_as_float(w & 0xffff0000u); }
typedef __bf16 bf16v2_t __attribute__((ext_vector_type(2)));
typedef float f32v2_t __attribute__((ext_vector_type(2)));
__device__ __forceinline__ unsigned pk2(float lo, float hi) { const f32v2_t f = {lo, hi}; const bf16v2_t v = __builtin_convertvector(f, bf16v2_t); return __builtin_bit_cast(unsigned, v); }
__device__ __forceinline__ float fast_rcp(float x) { return __builtin_amdgcn_rcpf(x); }
__device__ __forceinline__ float sigmoid_(float x) { return fast_rcp(1.f + __expf(-x)); }
__device__ __forceinline__ float silu_(float x) { return x * sigmoid_(x); }
__device__ __forceinline__ float softplus_(float x) { return fmaxf(x, 0.f) + __logf(1.f + __expf(-fabsf(x))); }
__device__ __forceinline__ float wave_sum(float v) {
#pragma unroll
  for (int o = 32; o; o >>= 1) v += __shfl_xor(v, o);
  return v;
}

struct Args { const float* in[19]; float* out; unsigned char* ws; };
typedef const __attribute__((address_space(4))) Args* ArgsP;
__device__ __forceinline__ ArgsP fresh_args() { auto p = __builtin_amdgcn_kernarg_segment_ptr(); asm volatile("" : "+s"(p)); return (ArgsP)p; }

__device__ __forceinline__ float rstd_of(const float* PS, int row) {
  const float4 a = *(const float4*)(PS + (size_t)row * 16), b = *(const float4*)(PS + (size_t)row * 16 + 4), c = *(const float4*)(PS + (size_t)row * 16 + 8), d = *(const float4*)(PS + (size_t)row * 16 + 12);
  const float s = ((a.x + a.y) + (a.z + a.w)) + ((b.x + b.y) + (b.z + b.w)) + ((c.x + c.y) + (c.z + c.w)) + ((d.x + d.y) + (d.z + d.w));
  return rsqrtf(s * (1.f / 1024.f) + EPS);
}
struct EpiAny {
  static constexpr bool AFTER_DRAIN = false;
  int mode; void* P; int ldc; float scale;
  __device__ __forceinline__ bool perm() const { return mode != 1; }
  template <class Sched> __device__ __forceinline__ void prepare(const Sched& S, int tid) const {
    if (mode == 1) return;
    extern __shared__ __attribute__((aligned(16))) unsigned char lds_ep[];
    const float* PSg = (const float*)(fresh_args()->ws + WS_PS); float* tab = (float*)(lds_ep + RS_TAB_OFF);
    const int th = __builtin_amdgcn_readfirstlane(tid >> 8), tr = tid & 255;
    float4 pv[3][4]; bool ok[3];
#pragma unroll
    for (int ps = 0; ps < 3; ++ps) {
      pg8::Unit uu; ok[ps] = S.next(ps * 2 + th, uu);
      const float* pp = PSg + (size_t)((mode == 3 ? uu.pn : uu.pm) * 256 + tr) * 16;
#pragma unroll
      for (int k = 0; k < 4; ++k) pv[ps][k] = ok[ps] ? *(const float4*)(pp + 4 * k) : make_float4(0.f, 0.f, 0.f, 0.f);
    }
#pragma unroll
    for (int ps = 0; ps < 3; ++ps) {
      float s = 0.f;
#pragma unroll
      for (int k = 0; k < 4; ++k) s += (pv[ps][k].x + pv[ps][k].y) + (pv[ps][k].z + pv[ps][k].w);
      if (ok[ps]) tab[(ps * 2 + th) * 256 + tr] = rsqrtf(s * (1.f / 1024.f) + EPS);
    }
  }
  __device__ __forceinline__ void init(f32x4 (&acc)[2][2][4][2], const pg8::Unit& u, int wr, int wc, int fr, int fq) const {
    if (mode == 1) {
      const float* X = (const float*)P; const float inv = 1.f / scale;
      const int row0 = u.pm * 256 + wr * 64 + fr, col0 = u.pn * 256 + wc * 32 + 4 * fq;
#pragma unroll
      for (int ai = 0; ai < 2; ++ai)
#pragma unroll
        for (int m = 0; m < 4; ++m)
#pragma unroll
          for (int bj = 0; bj < 2; ++bj)
#pragma unroll
            for (int n = 0; n < 2; ++n) acc[ai][bj][m][n] = *(const f32x4*)(X + (size_t)(row0 + ai * 128 + m * 16) * ldc + col0 + bj * 128 + n * 16) * inv;
    } else {
#pragma unroll
      for (int ai = 0; ai < 2; ++ai)
#pragma unroll
        for (int m = 0; m < 4; ++m)
#pragma unroll
          for (int bj = 0; bj < 2; ++bj)
#pragma unroll
            for (int n = 0; n < 2; ++n) acc[ai][bj][m][n] = (f32x4){0.f, 0.f, 0.f, 0.f};
    }
  }
  __device__ __forceinline__ void operator()(const f32x4 (&acc)[2][2][4][2], const pg8::Unit& u, int wr, int wc, int fr, int fq, int ui) const {
    extern __shared__ __attribute__((aligned(16))) unsigned char lds_ep[];
    const float* tab = (const float*)(lds_ep + RS_TAB_OFF) + ui * 256;
    unsigned char* ws_ = fresh_args()->ws; float* PS = (float*)(ws_ + WS_PS); bf16_t* XB = (bf16_t*)(ws_ + WS_XN);
    if (mode == 0) {
      bf16_t* O = (bf16_t*)P;
      const int row0 = u.pm * 256 + wr * 64 + fr, col0 = u.pn * 128 + wc * 32 + 8 * fq;
#pragma unroll
      for (int ai = 0; ai < 2; ++ai)
#pragma unroll
        for (int m = 0; m < 4; ++m) {
          const int row = row0 + ai * 128 + m * 16;
          const float rs = tab[wr * 64 + fr + ai * 128 + m * 16];
          bf16_t* rowp = O + (size_t)row * ldc + col0;
          unsigned wv[4];
#pragma unroll
          for (int n = 0; n < 2; ++n)
#pragma unroll
            for (int jp = 0; jp < 2; ++jp) {
              const f32v2_t g = (f32v2_t){acc[ai][0][m][n][2 * jp], acc[ai][0][m][n][2 * jp + 1]} * rs;
              const f32v2_t up = (f32v2_t){acc[ai][1][m][n][2 * jp], acc[ai][1][m][n][2 * jp + 1]} * rs;
              const f32v2_t t = g * (-1.44269504089f);
              f32v2_t e; e.x = __builtin_amdgcn_exp2f(t.x); e.y = __builtin_amdgcn_exp2f(t.y);
              const f32v2_t d = e + 1.0f;
              f32v2_t q; q.x = __builtin_amdgcn_rcpf(d.x); q.y = __builtin_amdgcn_rcpf(d.y);
              const f32v2_t o = (g * up) * q;
              wv[n * 2 + jp] = pk2(o.x, o.y);
            }
          u32x4 w; w.x = wv[0]; w.y = wv[1]; w.z = wv[2]; w.w = wv[3];
          *(u32x4*)rowp = w;
        }
    } else if (mode == 1) {
      float* X = (float*)P;
      const int row0 = u.pm * 256 + wr * 64 + fr, col0 = u.pn * 256 + wc * 32 + 4 * fq;
#pragma unroll
      for (int ai = 0; ai < 2; ++ai)
#pragma unroll
        for (int m = 0; m < 4; ++m) {
          const int row = row0 + ai * 128 + m * 16;
          float* rowp = X + (size_t)row * ldc + col0; bf16_t* rowb = XB + (size_t)row * ldc + col0;
          float ss = 0.f;
#pragma unroll
          for (int bj = 0; bj < 2; ++bj)
#pragma unroll
            for (int n = 0; n < 2; ++n) {
              const f32x4 v = acc[ai][bj][m][n] * scale;
              *(f32x4*)(rowp + bj * 128 + n * 16) = v;
              u32x2 w; w.x = pk2(v[0], v[1]); w.y = pk2(v[2], v[3]); *(u32x2*)(rowb + bj * 128 + n * 16) = w;
              ss += (v[0] * v[0] + v[1] * v[1]) + (v[2] * v[2] + v[3] * v[3]);
            }
          ss += __shfl_xor(ss, 16); ss += __shfl_xor(ss, 32);
          if (fq == 0) PS[(size_t)row * 16 + u.pn * 4 + wc] = ss;
        }
    } else if (mode == 2) {
      bf16_t* O = (bf16_t*)P;
      const int row0 = u.pm * 256 + wr * 64 + fr, col0 = u.pn * 256 + wc * 32 + 8 * fq;
#pragma unroll
      for (int ai = 0; ai < 2; ++ai)
#pragma unroll
        for (int m = 0; m < 4; ++m) {
          const int row = row0 + ai * 128 + m * 16;
          const float rs = tab[wr * 64 + fr + ai * 128 + m * 16];
          bf16_t* rowp = O + (size_t)row * ldc + col0;
#pragma unroll
          for (int bj = 0; bj < 2; ++bj) {
            const f32x4 v0 = acc[ai][bj][m][0] * rs, v1 = acc[ai][bj][m][1] * rs;
            u32x4 w; w.x = pk2(v0[0], v0[1]); w.y = pk2(v0[2], v0[3]); w.z = pk2(v1[0], v1[1]); w.w = pk2(v1[2], v1[3]);
            *(u32x4*)(rowp + bj * 128) = w;
          }
        }
    } else {
      bf16_t* O = (bf16_t*)P;
      const int row0 = u.pm * 256 + wr * 64 + fr, col0 = u.pn * 256 + wc * 32 + 8 * fq;
#pragma unroll
      for (int bj = 0; bj < 2; ++bj) {
        float rc[8];
#pragma unroll
        for (int e = 0; e < 8; ++e) rc[e] = tab[wc * 32 + 8 * fq + bj * 128 + e];
#pragma unroll
        for (int ai = 0; ai < 2; ++ai)
#pragma unroll
          for (int m = 0; m < 4; ++m) {
            bf16_t* rowp = O + (size_t)(row0 + ai * 128 + m * 16) * ldc + col0 + bj * 128;
            const f32x4 v0 = acc[ai][bj][m][0], v1 = acc[ai][bj][m][1];
            u32x4 w; w.x = pk2(v0[0] * rc[0], v0[1] * rc[1]); w.y = pk2(v0[2] * rc[2], v0[3] * rc[3]); w.z = pk2(v1[0] * rc[4], v1[1] * rc[5]); w.w = pk2(v1[2] * rc[6], v1[3] * rc[7]);
            *(u32x4*)rowp = w;
          }
      }
    }
  }
};

__device__ __forceinline__ void transpose_job(float* sT, const float* src, int ld, int K, int ncols, bf16_t* dst, int rs, int roff, int& rot, const float* gain) {
  const int tid = tid_fresh(), G = gridDim.x;
  const int ntn = ncols >> 6, ntiles = (K >> 6) * ntn;
  int first = (int)blockIdx.x - rot; if (first < 0) first += G;
  for (int t = first; t < ntiles; t += G) {
    const int kt = t / ntn, nt = t - kt * ntn; const int k0 = kt * 64, n0 = nt * 64;
    { const int r = tid >> 4, c4 = (tid & 15) * 4;
#pragma unroll
      for (int i = 0; i < 2; ++i) { const float4 v = *(const float4*)(src + (size_t)(k0 + r + 32 * i) * ld + n0 + c4); float* p = sT + (r + 32 * i) * 65 + c4; p[0] = v.x; p[1] = v.y; p[2] = v.z; p[3] = v.w; } }
    __syncthreads();
    { const int n = tid >> 3, ks = (tid & 7) * 8; const float* p = sT + ks * 65 + n;
      float4 ga = make_float4(1.f, 1.f, 1.f, 1.f), gb = ga;
      if (gain) { ga = *(const float4*)(gain + k0 + ks); gb = *(const float4*)(gain + k0 + ks + 4); }
      u32x4 w; w.x = pk2(p[0] * ga.x, p[65] * ga.y); w.y = pk2(p[130] * ga.z, p[195] * ga.w); w.z = pk2(p[260] * gb.x, p[325] * gb.y); w.w = pk2(p[390] * gb.z, p[455] * gb.w);
      const int na = n0 + n; const int row = roff + (na >> 7) * rs + (na & 127);
      *(u32x4*)(dst + (size_t)row * K + k0 + ks) = w; }
    __syncthreads();
  }
  rot = (rot + ntiles) % G;
}

struct ConvJob { const float* src; int ld, K, ntn; bf16_t* dst; int rs, roff; const float* gain; int kt, nt; };
__device__ __forceinline__ ConvJob conv_decode(int t, bool even, int l, int j, ArgsP a, unsigned char* ws) {
  ConvJob J; int base = 0, n;
  const float* gu1 = a->in[2] + (size_t)l * 1024 * 5632; const float* gu2 = a->in[17] + (size_t)l * 1024 * 5632;
#define CJ(cnt, S_, LD_, K_, NC_, D_, RS_, RO_, G_) n = (cnt); if (t < base + n) { J.src = (S_); J.ld = (LD_); J.K = (K_); J.ntn = (NC_) >> 6; J.dst = (D_); J.rs = (RS_); J.roff = (RO_); J.gain = (G_); const int tt = t - base; J.kt = tt / J.ntn; J.nt = tt - J.kt * J.ntn; return J; } base += n;
  CJ(704, gu1, 5632, 1024, 2816, (bf16_t*)(ws + WS_GU1), 256, 0, a->in[1] + l * 1024)
  CJ(704, gu1 + 2816, 5632, 1024, 2816, (bf16_t*)(ws + WS_GU1), 256, 128, a->in[1] + l * 1024)
  CJ(704, a->in[3] + (size_t)l * 2816 * 1024, 1024, 2816, 1024, (bf16_t*)(ws + WS_DN1), 128, 0, nullptr)
  CJ(704, gu2, 5632, 1024, 2816, (bf16_t*)(ws + WS_GU2), 256, 0, a->in[16] + l * 1024)
  CJ(704, gu2 + 2816, 5632, 1024, 2816, (bf16_t*)(ws + WS_GU2), 256, 128, a->in[16] + l * 1024)
  CJ(704, a->in[18] + (size_t)l * 2816 * 1024, 1024, 2816, 1024, (bf16_t*)(ws + WS_DN2), 128, 0, nullptr)
  const float* gm = a->in[4] + l * 1024;
  if (even) {
    const float* wi = a->in[5] + (size_t)j * 1024 * 4108;
    CJ(512, wi, 4108, 1024, 2048, (bf16_t*)(ws + WS_WIN), 128, 0, gm)
    CJ(256, wi + 2056, 4108, 1024, 1024, (bf16_t*)(ws + WS_WIN), 128, 2048, gm)
    CJ(128, wi + 3592, 4108, 1024, 512, (bf16_t*)(ws + WS_WIN), 128, 3072, gm)
    CJ(128, wi + 3080, 4108, 1024, 512, (bf16_t*)(ws + WS_WIN), 128, 3584, gm)
    CJ(256, a->in[13] + (size_t)j * 1024 * 1024, 1024, 1024, 1024, (bf16_t*)(ws + WS_WOUT), 128, 0, nullptr)
  } else {
    CJ(768, a->in[14] + (size_t)j * 1024 * 3072, 3072, 1024, 3072, (bf16_t*)(ws + WS_WIN), 128, 0, gm)
    CJ(256, a->in[15] + (size_t)j * 1024 * 1024, 1024, 1024, 1024, (bf16_t*)(ws + WS_WOUT), 128, 0, nullptr)
  }
#undef CJ
  J.src = nullptr; J.ld = 0; J.K = 0; J.ntn = 1; J.dst = nullptr; J.rs = 0; J.roff = 0; J.gain = nullptr; J.kt = 0; J.nt = 0;
  return J;
}
__device__ __forceinline__ void convert_layer(float* sT, bool even, int l, int j, ArgsP a, unsigned char* ws) {
  const int tid = tid_fresh(), G = gridDim.x;
  const int total = 6 * 704 + (even ? 1280 : 1024);
  const int r = tid >> 4, c4 = (tid & 15) * 4;
  int t = blockIdx.x; asm volatile("" : "+s"(t));
  if (t >= total) return;
  float4 v0, v1;
  { const ConvJob J = conv_decode(t, even, l, j, a, ws);
    v0 = *(const float4*)(J.src + (size_t)(J.kt * 64 + r) * J.ld + J.nt * 64 + c4); v1 = *(const float4*)(J.src + (size_t)(J.kt * 64 + r + 32) * J.ld + J.nt * 64 + c4); }
  for (;;) {
    const int tn = t + G; const bool more = tn < total;
    float4 n0 = v0, n1 = v1;
    if (more) { const ConvJob Jn = conv_decode(tn, even, l, j, a, ws);
      n0 = *(const float4*)(Jn.src + (size_t)(Jn.kt * 64 + r) * Jn.ld + Jn.nt * 64 + c4); n1 = *(const float4*)(Jn.src + (size_t)(Jn.kt * 64 + r + 32) * Jn.ld + Jn.nt * 64 + c4); }
    { float* p = sT + r * 65 + c4; p[0] = v0.x; p[1] = v0.y; p[2] = v0.z; p[3] = v0.w; float* q = sT + (r + 32) * 65 + c4; q[0] = v1.x; q[1] = v1.y; q[2] = v1.z; q[3] = v1.w; }
    __syncthreads();
    { const ConvJob J = conv_decode(t, even, l, j, a, ws);
      const int k0 = J.kt * 64, n = tid >> 3, ks = (tid & 7) * 8; const float* p = sT + ks * 65 + n;
      float4 ga = make_float4(1.f, 1.f, 1.f, 1.f), gb = ga;
      if (J.gain) { ga = *(const float4*)(J.gain + k0 + ks); gb = *(const float4*)(J.gain + k0 + ks + 4); }
      u32x4 w; w.x = pk2(p[0] * ga.x, p[65] * ga.y); w.y = pk2(p[130] * ga.z, p[195] * ga.w); w.z = pk2(p[260] * gb.x, p[325] * gb.y); w.w = pk2(p[390] * gb.z, p[455] * gb.w);
      const int na = J.nt * 64 + n; const int row = J.roff + (na >> 7) * J.rs + (na & 127);
      *(u32x4*)(J.dst + (size_t)row * J.K + k0 + ks) = w; }
    __syncthreads();
    if (!more) break;
    t = tn; v0 = n0; v1 = n1;
  }
}

template <bool SMALL>
__device__ __forceinline__ void norm_phase(unsigned char* lds, const float* xsrc, float* xcopy, const float* gain, bf16_t* XN,
                                           const float* w_in, const float* a_log, const float* dt_bias, const float* f_bias, float* SM) {
  const int tid = tid_fresh(), lane = tid & 63, wave = tid >> 6;
  float* ws_s = (float*)lds;
  if (SMALL) {
    for (int e = tid; e < 12288; e += 512) { const int k = e / 12, c = e - k * 12; const int col = c < 8 ? 2048 + c : 4096 + c; ws_s[c * 1024 + k] = w_in[(size_t)k * 4108 + col]; }
    __syncthreads();
  }
  float4 gv[4];
#pragma unroll
  for (int j = 0; j < 4; ++j) gv[j] = *(const float4*)(gain + lane * 4 + 256 * j);
  float4 xnx[4];
  { const int row0 = blockIdx.x * 8 + wave;
#pragma unroll
    for (int j = 0; j < 4; ++j) xnx[j] = *(const float4*)(xsrc + (size_t)(row0 < T ? row0 : 0) * 1024 + lane * 4 + 256 * j); }
  for (int row = blockIdx.x * 8 + wave; row < T; row += gridDim.x * 8) {
    float4 xv[4]; float ss = 0.f;
#pragma unroll
    for (int j = 0; j < 4; ++j) xv[j] = xnx[j];
    { const int rn = row + gridDim.x * 8;
      if (rn < T) {
#pragma unroll
        for (int j = 0; j < 4; ++j) xnx[j] = *(const float4*)(xsrc + (size_t)rn * 1024 + lane * 4 + 256 * j);
      } }
#pragma unroll
    for (int j = 0; j < 4; ++j) ss += xv[j].x * xv[j].x + xv[j].y * xv[j].y + xv[j].z * xv[j].z + xv[j].w * xv[j].w;
    if (xcopy) {
#pragma unroll
      for (int j = 0; j < 4; ++j) *(float4*)(xcopy + (size_t)row * 1024 + lane * 4 + 256 * j) = xv[j];
    }
    ss = wave_sum(ss);
    const float rstd = rsqrtf(ss * (1.f / 1024.f) + EPS);
#pragma unroll
    for (int j = 0; j < 4; ++j) {
      xv[j].x = xv[j].x * rstd * gv[j].x; xv[j].y = xv[j].y * rstd * gv[j].y; xv[j].z = xv[j].z * rstd * gv[j].z; xv[j].w = xv[j].w * rstd * gv[j].w;
      if (XN) { u32x2 w; w.x = pk2(xv[j].x, xv[j].y); w.y = pk2(xv[j].z, xv[j].w); *(u32x2*)(XN + (size_t)row * 1024 + lane * 4 + 256 * j) = w; }
    }
    if (SMALL) {
      float* red = (float*)(lds + 49152) + wave * (12 * 68);
#pragma unroll
      for (int c = 0; c < 12; ++c) {
        float d = 0.f;
#pragma unroll
        for (int j = 0; j < 4; ++j) { const float4 wv = *(const float4*)(ws_s + c * 1024 + lane * 4 + 256 * j); d += xv[j].x * wv.x + xv[j].y * wv.y + xv[j].z * wv.z + xv[j].w * wv.w; }
        red[c * 68 + lane] = d;
      }
      float mine = 0.f;
      if (lane < 12) {
        float s0 = 0.f, s1 = 0.f, s2 = 0.f, s3 = 0.f;
#pragma unroll
        for (int i4 = 0; i4 < 16; ++i4) { const float4 v = *(const float4*)(red + lane * 68 + 4 * i4); s0 += v.x; s1 += v.y; s2 += v.z; s3 += v.w; }
        mine = (s0 + s1) + (s2 + s3);
      }
      if (lane < 12) {
        const int h = lane & 3; float o;
        if (lane < 4) o = sigmoid_(mine);
        else if (lane < 8) o = -__expf(a_log[h]) * softplus_(mine + dt_bias[h]);
        else o = -softplus_(-(mine + f_bias[h]));
        SM[(size_t)row * 16 + lane] = o;
      }
    }
  }
  if (SMALL) __syncthreads();
}


__device__ __forceinline__ void init_phase(const float* xin, float* X, bf16_t* XB, float* PS) {
  const int tid = tid_fresh(), lane = tid & 63, wave = tid >> 6;
  for (int row = blockIdx.x * 8 + wave; row < T; row += gridDim.x * 8) {
    float ss = 0.f;
#pragma unroll
    for (int j = 0; j < 4; ++j) {
      const float4 v = *(const float4*)(xin + (size_t)row * 1024 + lane * 4 + 256 * j);
      *(float4*)(X + (size_t)row * 1024 + lane * 4 + 256 * j) = v;
      u32x2 w; w.x = pk2(v.x, v.y); w.y = pk2(v.z, v.w); *(u32x2*)(XB + (size_t)row * 1024 + lane * 4 + 256 * j) = w;
      ss += (v.x * v.x + v.y * v.y) + (v.z * v.z + v.w * v.w);
    }
    ss = wave_sum(ss);
    if (lane < 16) PS[(size_t)row * 16 + lane] = (lane == 0) ? ss : 0.f;
  }
}

__device__ __forceinline__ void cumsum_logf(unsigned char* lds, const float* SM, float* CF) {
  if (blockIdx.x < 16) {
    const int tid = tid_fresh(), lane = tid & 63, wave = tid >> 6;
    const int seq = blockIdx.x, b = seq >> 2, h = seq & 3; float* red = (float*)lds;
    float v[8]; float run = 0.f;
#pragma unroll
    for (int e = 0; e < 8; ++e) { run += SM[((size_t)(b * 4096 + tid * 8 + e)) * 16 + 8 + h]; v[e] = run; }
    float sc = run;
#pragma unroll
    for (int o = 1; o < 64; o <<= 1) { const float t = __shfl_up(sc, o); if (lane >= o) sc += t; }
    if (lane == 63) red[wave] = sc;
    __syncthreads();
    float base = sc - run;
    for (int w2 = 0; w2 < wave; ++w2) base += red[w2];
#pragma unroll
    for (int e = 0; e < 8; ++e) CF[seq * 4096 + tid * 8 + e] = v[e] + base;
    __syncthreads();
  }
}

#define MFMA16(a, b, c) __builtin_amdgcn_mfma_f32_16x16x32_bf16((a), (b), (c), 0, 0, 0)

__device__ __forceinline__ void dn_prep_unit(unsigned char* lds, int u, const bf16_t* BIG, const float* SM, const float* convw, unsigned char* DNX, float* GL) {
  const int tid = tid_fresh(), lane = tid & 63, wave = tid >> 6;
  bf16_t* q_s = (bf16_t*)lds; bf16_t* k_s = (bf16_t*)(lds + 17408); float* A_s = (float*)(lds + 34816);
  float* gc_s = (float*)(lds + 52224); float* beta_s = (float*)(lds + 52480); float* rhs = (float*)(lds + 52736); float* cw_s = (float*)(lds + 118272);
  const int bh = u >> 6, n = u & 63, b = bh >> 2, h = bh & 3; const int t0 = b * SEQ + n * 64;
  unsigned char* ux = DNX + (size_t)u * DNX_UNIT;
  bf16_t* UT = (bf16_t*)ux; bf16_t* Wd = (bf16_t*)(ux + 16384); bf16_t* QD = (bf16_t*)(ux + 32768); bf16_t* KDT = (bf16_t*)(ux + 49152); bf16_t* AT = (bf16_t*)(ux + 65536);
  const int s = tid >> 3, c0 = (tid & 7) * 16;
  u32x4 xr[3][4][2];
#pragma unroll
  for (int sel = 0; sel < 3; ++sel)
#pragma unroll
    for (int i = 0; i < 4; ++i) {
      const int sr = n * 64 + s - 3 + i; const int srl = sr < 0 ? 0 : sr;
      const bf16_t* xp = BIG + (size_t)(b * SEQ + srl) * 3584 + sel * 512 + h * 128 + c0;
      xr[sel][i][0] = *(const u32x4*)xp; xr[sel][i][1] = *(const u32x4*)(xp + 8);
    }
  if (tid < 64) {
    float g = SM[(size_t)(t0 + tid) * 16 + 4 + h];
#pragma unroll
    for (int o = 1; o < 64; o <<= 1) { const float t = __shfl_up(g, o); if (lane >= o) g += t; }
    gc_s[tid] = g; beta_s[tid] = SM[(size_t)(t0 + tid) * 16 + h];
    if (tid == 63) GL[u] = __expf(g);
  }
  for (int e = tid; e < 1536; e += 512) { const int i = e / 384, r = e - i * 384, sel = r >> 7, c = r & 127; cw_s[e] = convw[i * 1536 + sel * 512 + h * 128 + c]; }
  __syncthreads();
#ifndef NREP_CV
#define NREP_CV 1
#endif
  for (int rep_cv = 0; rep_cv < NREP_CV; ++rep_cv)
  {
    const float bs = beta_s[s], eg = __expf(gc_s[s]);
#pragma unroll
    for (int sel = 0; sel < 3; ++sel) {
      float a[16];
#pragma unroll
      for (int e = 0; e < 16; ++e) a[e] = 0.f;
#pragma unroll
      for (int i = 0; i < 4; ++i) {
        const int sr = n * 64 + s - 3 + i; const float mk = sr < 0 ? 0.f : 1.f;
        const u32x4 x0 = xr[sel][i][0], x1 = xr[sel][i][1];
        const float* wp = cw_s + i * 384 + sel * 128 + c0;
        float4 w0 = *(const float4*)wp, w1 = *(const float4*)(wp + 4), w2 = *(const float4*)(wp + 8), w3 = *(const float4*)(wp + 12);
        w0.x *= mk; w0.y *= mk; w0.z *= mk; w0.w *= mk; w1.x *= mk; w1.y *= mk; w1.z *= mk; w1.w *= mk;
        w2.x *= mk; w2.y *= mk; w2.z *= mk; w2.w *= mk; w3.x *= mk; w3.y *= mk; w3.z *= mk; w3.w *= mk;
        a[0] += bflo(x0.x) * w0.x; a[1] += bfhi(x0.x) * w0.y; a[2] += bflo(x0.y) * w0.z; a[3] += bfhi(x0.y) * w0.w;
        a[4] += bflo(x0.z) * w1.x; a[5] += bfhi(x0.z) * w1.y; a[6] += bflo(x0.w) * w1.z; a[7] += bfhi(x0.w) * w1.w;
        a[8] += bflo(x1.x) * w2.x; a[9] += bfhi(x1.x) * w2.y; a[10] += bflo(x1.y) * w2.z; a[11] += bfhi(x1.y) * w2.w;
        a[12] += bflo(x1.z) * w3.x; a[13] += bfhi(x1.z) * w3.y; a[14] += bflo(x1.w) * w3.z; a[15] += bfhi(x1.w) * w3.w;
      }
      float ss = 0.f;
#pragma unroll
      for (int e = 0; e < 16; ++e) { a[e] = silu_(a[e]); ss += a[e] * a[e]; }
      if (sel < 2) {
        ss += __shfl_xor(ss, 1); ss += __shfl_xor(ss, 2); ss += __shfl_xor(ss, 4);
        const float r = rsqrtf(ss + EPS) * (sel == 0 ? QSCALE : 1.f);
#pragma unroll
        for (int e = 0; e < 16; ++e) a[e] *= r;
        bf16_t* dsts = (sel == 0 ? q_s : k_s) + s * 136 + c0;
        u32x4 p0, p1;
        p0.x = pk2(a[0], a[1]); p0.y = pk2(a[2], a[3]); p0.z = pk2(a[4], a[5]); p0.w = pk2(a[6], a[7]);
        p1.x = pk2(a[8], a[9]); p1.y = pk2(a[10], a[11]); p1.z = pk2(a[12], a[13]); p1.w = pk2(a[14], a[15]);
        *(u32x4*)dsts = p0; *(u32x4*)(dsts + 8) = p1;
        if (sel == 0) {
          u32x4 d0, d1;
          d0.x = pk2(a[0] * eg, a[1] * eg); d0.y = pk2(a[2] * eg, a[3] * eg); d0.z = pk2(a[4] * eg, a[5] * eg); d0.w = pk2(a[6] * eg, a[7] * eg);
          d1.x = pk2(a[8] * eg, a[9] * eg); d1.y = pk2(a[10] * eg, a[11] * eg); d1.z = pk2(a[12] * eg, a[13] * eg); d1.w = pk2(a[14] * eg, a[15] * eg);
          *(u32x4*)(QD + s * 128 + c0) = d0; *(u32x4*)(QD + s * 128 + c0 + 8) = d1;
        } else {
          const float f = bs * eg; float* rp = rhs + s * 256 + 128 + c0;
#pragma unroll
          for (int e4 = 0; e4 < 4; ++e4) *(float4*)(rp + 4 * e4) = make_float4(a[4 * e4] * f, a[4 * e4 + 1] * f, a[4 * e4 + 2] * f, a[4 * e4 + 3] * f);
        }
      } else {
        float* rp = rhs + s * 256 + c0;
#pragma unroll
        for (int e4 = 0; e4 < 4; ++e4) *(float4*)(rp + 4 * e4) = make_float4(a[4 * e4] * bs, a[4 * e4 + 1] * bs, a[4 * e4 + 2] * bs, a[4 * e4 + 3] * bs);
      }
    }
  }
  __syncthreads();
#ifndef NREP_MM
#define NREP_MM 1
#endif
  for (int rep_mm = 0; rep_mm < NREP_MM; ++rep_mm)
  {
    const int it = wave & 3, sel = wave >> 2, fr = lane & 15, fq = lane >> 4;
    const bf16_t* As = (sel ? q_s : k_s) + (it * 16 + fr) * 136 + fq * 8;
    bf16x8 af[4];
#pragma unroll
    for (int kk = 0; kk < 4; ++kk) af[kk] = *(const bf16x8*)(As + 32 * kk);
#pragma unroll
    for (int jt = 0; jt < 4; ++jt) {
      f32x4 acc = {0.f, 0.f, 0.f, 0.f};
      if (jt <= it) {
        const bf16_t* Bs = k_s + (jt * 16 + fr) * 136 + fq * 8;
#pragma unroll
        for (int kk = 0; kk < 4; ++kk) acc = MFMA16(af[kk], *(const bf16x8*)(Bs + 32 * kk), acc);
      }
      const int jj = jt * 16 + fr; const float gj = gc_s[jj];
#pragma unroll
      for (int j = 0; j < 4; ++j) {
        const int i = it * 16 + fq * 4 + j;
        const float dec = __expf(fminf(gc_s[i] - gj, 0.f));
        if (sel == 0) A_s[i * 68 + jj] = (i > jj) ? beta_s[i] * acc[j] * dec : 0.f;
        else { const float v = (i >= jj) ? acc[j] * dec : 0.f; AT[i * 64 + jj] = (bf16_t)(pk2(v, 0.f) & 0xffffu); }
      }
    }
  }
  {
    const int d = tid >> 2, sg = (tid & 3) * 16; const float gl = gc_s[63];
    float v[16];
#pragma unroll
    for (int e = 0; e < 16; ++e) v[e] = bf2f(k_s[(sg + e) * 136 + d]) * __expf(gl - gc_s[sg + e]);
    u32x4 p0, p1;
    p0.x = pk2(v[0], v[1]); p0.y = pk2(v[2], v[3]); p0.z = pk2(v[4], v[5]); p0.w = pk2(v[6], v[7]);
    p1.x = pk2(v[8], v[9]); p1.y = pk2(v[10], v[11]); p1.z = pk2(v[12], v[13]); p1.w = pk2(v[14], v[15]);
    *(u32x4*)(KDT + d * 64 + sg) = p0; *(u32x4*)(KDT + d * 64 + sg + 8) = p1;
  }
  __syncthreads();
#ifndef NREP_FS
#define NREP_FS 1
#endif
  float* Ti_s = (float*)(lds + 124416);
  if (wave < 4 && lane < 16) {
    const int I = wave; const float* Ab = A_s + (I * 16) * 68 + I * 16;
    float t[16];
#pragma unroll
    for (int r = 0; r < 16; ++r) {
      float v = (r == lane) ? 1.f : 0.f;
#pragma unroll
      for (int j = 0; j < r; ++j) v -= Ab[r * 68 + j] * t[j];
      t[r] = v;
    }
#pragma unroll
    for (int r = 0; r < 16; ++r) Ti_s[(I * 16 + r) * 20 + lane] = t[r];
  }
  __syncthreads();
  for (int rep_fs = 0; rep_fs < NREP_FS; ++rep_fs)
  {
    const int fr = lane & 15, fq = lane >> 4;
#pragma unroll
    for (int I = 0; I < 4; ++I) {
      f32x4 ac[2];
      ac[0] = (f32x4){0.f, 0.f, 0.f, 0.f}; ac[1] = (f32x4){0.f, 0.f, 0.f, 0.f};
#pragma unroll
      for (int J = 0; J < I; ++J)
#pragma unroll
        for (int kk = 0; kk < 4; ++kk) {
          const float a = A_s[(I * 16 + fr) * 68 + J * 16 + 4 * kk + fq];
#pragma unroll
          for (int c2 = 0; c2 < 2; ++c2) ac[c2] = __builtin_amdgcn_mfma_f32_16x16x4f32(a, rhs[(J * 16 + 4 * kk + fq) * 256 + wave * 32 + c2 * 16 + fr], ac[c2], 0, 0, 0);
        }
#pragma unroll
      for (int c2 = 0; c2 < 2; ++c2)
#pragma unroll
        for (int j = 0; j < 4; ++j) { float* p = rhs + (I * 16 + fq * 4 + j) * 256 + wave * 32 + c2 * 16 + fr; *p = *p - ac[c2][j]; }
      f32x4 xc[2];
      xc[0] = (f32x4){0.f, 0.f, 0.f, 0.f}; xc[1] = (f32x4){0.f, 0.f, 0.f, 0.f};
#pragma unroll
      for (int kk = 0; kk < 4; ++kk) {
        const float a = Ti_s[(I * 16 + fr) * 20 + 4 * kk + fq];
#pragma unroll
        for (int c2 = 0; c2 < 2; ++c2) xc[c2] = __builtin_amdgcn_mfma_f32_16x16x4f32(a, rhs[(I * 16 + 4 * kk + fq) * 256 + wave * 32 + c2 * 16 + fr], xc[c2], 0, 0, 0);
      }
#pragma unroll
      for (int c2 = 0; c2 < 2; ++c2)
#pragma unroll
        for (int j = 0; j < 4; ++j) rhs[(I * 16 + fq * 4 + j) * 256 + wave * 32 + c2 * 16 + fr] = xc[c2][j];
    }
  }
  __syncthreads();
  {
    const int wi = tid >> 3, wseg = (tid & 7) * 16;
    const float* wp = rhs + wi * 256 + 128 + wseg;
    const float4 w0 = *(const float4*)wp, w1 = *(const float4*)(wp + 4), w2 = *(const float4*)(wp + 8), w3 = *(const float4*)(wp + 12);
    u32x4 p0, p1;
    p0.x = pk2(w0.x, w0.y); p0.y = pk2(w0.z, w0.w); p0.z = pk2(w1.x, w1.y); p0.w = pk2(w1.z, w1.w);
    p1.x = pk2(w2.x, w2.y); p1.y = pk2(w2.z, w2.w); p1.z = pk2(w3.x, w3.y); p1.w = pk2(w3.z, w3.w);
    *(u32x4*)(Wd + wi * 128 + wseg) = p0; *(u32x4*)(Wd + wi * 128 + wseg + 8) = p1;
    const int un = tid >> 2, uc = (tid & 3) * 16;
    float uv[16];
#pragma unroll
    for (int e = 0; e < 16; ++e) uv[e] = rhs[(uc + e) * 256 + un];
    u32x4 q0, q1;
    q0.x = pk2(uv[0], uv[1]); q0.y = pk2(uv[2], uv[3]); q0.z = pk2(uv[4], uv[5]); q0.w = pk2(uv[6], uv[7]);
    q1.x = pk2(uv[8], uv[9]); q1.y = pk2(uv[10], uv[11]); q1.z = pk2(uv[12], uv[13]); q1.w = pk2(uv[14], uv[15]);
    *(u32x4*)(UT + un * 64 + uc) = q0; *(u32x4*)(UT + un * 64 + uc + 8) = q1;
  }
  __syncthreads();
}

__device__ __forceinline__ void dn_scan(unsigned char* lds, int sid, const unsigned char* DNX, const float* GL, float* OF, float* PSD) {
  const int tid = tid_fresh(), lane = tid & 63, wave = tid >> 6, fr = lane & 15, fq = lane >> 4;
  bf16_t* w_s = (bf16_t*)lds; bf16_t* qd_s = (bf16_t*)(lds + 17408); bf16_t* kdT_s = (bf16_t*)(lds + 34816); bf16_t* at_s = (bf16_t*)(lds + 53248);
  bf16_t* ST_s = (bf16_t*)(lds + 62464); bf16_t* vT_s = (bf16_t*)(lds + 71168);
  const int bh = sid >> 2, sl = sid & 3, b = bh >> 2, h = bh & 3;
  for (int e = tid; e < 32 * 136 / 2; e += 512) ((unsigned*)ST_s)[e] = 0u;
  f32x4 Sacc[2];
  Sacc[0] = (f32x4){0.f, 0.f, 0.f, 0.f}; Sacc[1] = (f32x4){0.f, 0.f, 0.f, 0.f};
  const int r64 = tid >> 4, c16 = (tid & 15) * 8;
  const int r128 = tid >> 3, c8 = (tid & 7) * 8;
  u32x4 rw[2], rq[2], rk[2], ra; u32x2 ru[2]; float rgl;
  ru[0] = (u32x2){0u, 0u}; ru[1] = (u32x2){0u, 0u};
#define DN_LOAD(nc) do { const unsigned char* ux = DNX + (size_t)((bh << 6) + (nc)) * DNX_UNIT; \
    const bf16_t* UTg = (const bf16_t*)ux; const bf16_t* Wg = (const bf16_t*)(ux + 16384); const bf16_t* QDg = (const bf16_t*)(ux + 32768); \
    const bf16_t* KDTg = (const bf16_t*)(ux + 49152); const bf16_t* ATg = (const bf16_t*)(ux + 65536); \
    _Pragma("unroll") for (int i = 0; i < 2; ++i) { rw[i] = *(const u32x4*)(Wg + (r64 + 32 * i) * 128 + c16); rq[i] = *(const u32x4*)(QDg + (r64 + 32 * i) * 128 + c16); \
      rk[i] = *(const u32x4*)(KDTg + (r128 + 64 * i) * 64 + c8); } \
    ra = *(const u32x4*)(ATg + r128 * 64 + c8); \
    if (wave < 4) { _Pragma("unroll") for (int c2 = 0; c2 < 2; ++c2) ru[c2] = *(const u32x2*)(UTg + (sl * 32 + c2 * 16 + fr) * 64 + wave * 16 + fq * 4); } \
    rgl = GL[(bh << 6) + (nc)]; } while (0)
  DN_LOAD(0);
  for (int nc = 0; nc < 64; ++nc) {
#pragma unroll
    for (int i = 0; i < 2; ++i) { *(u32x4*)(w_s + (r64 + 32 * i) * 136 + c16) = rw[i]; *(u32x4*)(qd_s + (r64 + 32 * i) * 136 + c16) = rq[i]; *(u32x4*)(kdT_s + (r128 + 64 * i) * 72 + c8) = rk[i]; }
    *(u32x4*)(at_s + r128 * 72 + c8) = ra;
    const u32x2 uc0 = ru[0], uc1 = ru[1];
    const float gl = rgl;
    __syncthreads();
    if (nc + 1 < 64) DN_LOAD(nc + 1);
    f32x4 P[2];
    {
      const bf16_t* Ar = (wave < 4 ? w_s : qd_s) + ((wave & 3) * 16 + fr) * 136 + fq * 8;
      bf16x8 af[4];
#pragma unroll
      for (int kk = 0; kk < 4; ++kk) af[kk] = *(const bf16x8*)(Ar + 32 * kk);
#pragma unroll
      for (int c2 = 0; c2 < 2; ++c2) {
        P[c2] = (f32x4){0.f, 0.f, 0.f, 0.f};
#pragma unroll
        for (int kk = 0; kk < 4; ++kk) P[c2] = MFMA16(af[kk], *(const bf16x8*)(ST_s + (c2 * 16 + fr) * 136 + fq * 8 + 32 * kk), P[c2]);
      }
    }
    if (wave < 4) {
      { const float v0 = bflo(uc0.x) - P[0][0], v1 = bfhi(uc0.x) - P[0][1], v2 = bflo(uc0.y) - P[0][2], v3 = bfhi(uc0.y) - P[0][3];
        u32x2 p; p.x = pk2(v0, v1); p.y = pk2(v2, v3); *(u32x2*)(vT_s + (fr) * 72 + wave * 16 + fq * 4) = p; }
      { const float v0 = bflo(uc1.x) - P[1][0], v1 = bfhi(uc1.x) - P[1][1], v2 = bflo(uc1.y) - P[1][2], v3 = bfhi(uc1.y) - P[1][3];
        u32x2 p; p.x = pk2(v0, v1); p.y = pk2(v2, v3); *(u32x2*)(vT_s + (16 + fr) * 72 + wave * 16 + fq * 4) = p; }
    }
    __syncthreads();
    if (wave >= 4) {
      const int ct = wave - 4;
      bf16x8 aa[2];
#pragma unroll
      for (int g = 0; g < 2; ++g) aa[g] = *(const bf16x8*)(at_s + (ct * 16 + fr) * 72 + fq * 8 + 32 * g);
#pragma unroll
      for (int c2 = 0; c2 < 2; ++c2)
#pragma unroll
        for (int g = 0; g < 2; ++g) P[c2] = MFMA16(aa[g], *(const bf16x8*)(vT_s + (c2 * 16 + fr) * 72 + fq * 8 + 32 * g), P[c2]);
      const int t0 = b * SEQ + nc * 64 + ct * 16 + fq * 4;
#pragma unroll
      for (int j = 0; j < 4; ++j) {
        float* op = OF + (size_t)(t0 + j) * 512 + h * 128 + sl * 32 + fr;
        op[0] = P[0][j]; op[16] = P[1][j];
        float ss = P[0][j] * P[0][j] + P[1][j] * P[1][j];
        ss += __shfl_xor(ss, 1); ss += __shfl_xor(ss, 2); ss += __shfl_xor(ss, 4); ss += __shfl_xor(ss, 8);
        if (fr == 0) PSD[(size_t)(t0 + j) * 16 + h * 4 + sl] = ss;
      }
    }
    {
      bf16x8 ak[2];
#pragma unroll
      for (int g = 0; g < 2; ++g) ak[g] = *(const bf16x8*)(kdT_s + (wave * 16 + fr) * 72 + fq * 8 + 32 * g);
#pragma unroll
      for (int n2 = 0; n2 < 2; ++n2) {
        f32x4 a = Sacc[n2] * gl;
#pragma unroll
        for (int g = 0; g < 2; ++g) a = MFMA16(ak[g], *(const bf16x8*)(vT_s + (n2 * 16 + fr) * 72 + fq * 8 + 32 * g), a);
        Sacc[n2] = a;
        u32x2 p; p.x = pk2(a[0], a[1]); p.y = pk2(a[2], a[3]);
        *(u32x2*)(ST_s + (n2 * 16 + fr) * 136 + wave * 16 + fq * 4) = p;
      }
    }
    __syncthreads();
  }
#undef DN_LOAD
}

__device__ __forceinline__ void dn_fixup(const float* OF, const float* PSD, const bf16_t* BIG, const float* ng, bf16_t* OB) {
  const int tid = tid_fresh();
  for (int it = blockIdx.x * 512 + tid; it < T * 32; it += gridDim.x * 512) {
    const int t = it >> 5, h = (it >> 3) & 3, n0 = (it & 7) * 16;
    const float4 ps = *(const float4*)(PSD + (size_t)t * 16 + h * 4);
    const float rstd = rsqrtf((ps.x + ps.y + ps.z + ps.w) * (1.f / 128.f) + EPS);
    const float* op = OF + (size_t)t * 512 + h * 128 + n0;
    const bf16_t* gp = BIG + (size_t)t * 3584 + 1536 + h * 128 + n0;
    const u32x4 g0 = *(const u32x4*)gp, g1 = *(const u32x4*)(gp + 8);
    float gt[16];
    gt[0] = bflo(g0.x); gt[1] = bfhi(g0.x); gt[2] = bflo(g0.y); gt[3] = bfhi(g0.y); gt[4] = bflo(g0.z); gt[5] = bfhi(g0.z); gt[6] = bflo(g0.w); gt[7] = bfhi(g0.w);
    gt[8] = bflo(g1.x); gt[9] = bfhi(g1.x); gt[10] = bflo(g1.y); gt[11] = bfhi(g1.y); gt[12] = bflo(g1.z); gt[13] = bfhi(g1.z); gt[14] = bflo(g1.w); gt[15] = bfhi(g1.w);
    float o[16];
#pragma unroll
    for (int e4 = 0; e4 < 4; ++e4) { const float4 v = *(const float4*)(op + 4 * e4); const float4 gn = *(const float4*)(ng + n0 + 4 * e4);
      o[4 * e4] = v.x * rstd * gn.x * silu_(gt[4 * e4]); o[4 * e4 + 1] = v.y * rstd * gn.y * silu_(gt[4 * e4 + 1]);
      o[4 * e4 + 2] = v.z * rstd * gn.z * silu_(gt[4 * e4 + 2]); o[4 * e4 + 3] = v.w * rstd * gn.w * silu_(gt[4 * e4 + 3]); }
    u32x4 p0, p1;
    p0.x = pk2(o[0], o[1]); p0.y = pk2(o[2], o[3]); p0.z = pk2(o[4], o[5]); p0.w = pk2(o[6], o[7]);
    p1.x = pk2(o[8], o[9]); p1.y = pk2(o[10], o[11]); p1.z = pk2(o[12], o[13]); p1.w = pk2(o[14], o[15]);
    bf16_t* ob = OB + (size_t)t * 1024 + h * 128 + n0;
    *(u32x4*)ob = p0; *(u32x4*)(ob + 8) = p1;
  }
}

struct AttnP {
  const bf16_t* Q; const bf16_t* K; int ld;
  const bf16_t* VT;
  const float* qg; const float* kg; const float* CF; const bf16_t* gate;
  bf16_t* O;
  int H;
};
template <bool SBK>
__device__ __forceinline__ void attn_unit(unsigned char* lds, const AttnP& P, int bh, int qb) {
  const int tid = tid_fresh(), lane = tid & 63, wave = tid >> 6, fr = lane & 15, fq = lane >> 4;
  bf16_t* K_s = (bf16_t*)lds; bf16_t* V_s = (bf16_t*)(lds + 69632); float* ck_s = (float*)(lds + 143360); volatile int* dflag = (volatile int*)(lds + 144384);
  const int b = bh / P.H, h = bh - b * P.H; const int tb = b * SEQ;
  const int q = qb * 128 + wave * 16 + fr;
  const int qmin_w = qb * 128 + wave * 16, qmax_w = qmin_w + 15;
  const int ld = P.ld;
  bf16x8 Ue, Uo, U1;
  {
    u32x4 e, o, one;
    const unsigned ONE = 0x3F80u;
    unsigned t[4];
#pragma unroll
    for (int i = 0; i < 4; ++i) t[i] = (fq * 4 + i > fr) ? ONE : 0u;
    e.x = t[0] | (t[1] << 16); e.y = t[2] | (t[3] << 16); e.z = ONE | (ONE << 16); e.w = ONE | (ONE << 16);
    o.x = 0u; o.y = 0u; o.z = t[0] | (t[1] << 16); o.w = t[2] | (t[3] << 16);
    one.x = one.y = one.z = one.w = ONE | (ONE << 16);
    Ue = __builtin_bit_cast(bf16x8, e); Uo = __builtin_bit_cast(bf16x8, o); U1 = __builtin_bit_cast(bf16x8, one);
  }
  const int nt = 2 * qb + 2;
  f32x4 acc_o[8];
#pragma unroll
  for (int dt = 0; dt < 8; ++dt) acc_o[dt] = (f32x4){0.f, 0.f, 0.f, 0.f};
  float m_run = -INFINITY, l_run = 0.f, R = 0.f;
  const int kr = tid >> 4, kc = (tid & 15) * 8;
  const int vr = tid >> 3, vc = (tid & 7) * 8;
  u32x4 rk[2][2], rv[2][2]; float rc = 0.f, rcn = 0.f;
#define AT_LOAD(tp) do {   \
    _Pragma("unroll") for (int sb = 0; sb < 2; ++sb) { const int k0_ = (2 * (tp) + 1 - sb) * 64; \
      _Pragma("unroll") for (int i = 0; i < 2; ++i) { rk[sb][i] = *(const u32x4*)(P.K + (size_t)(tb + k0_ + kr + 32 * i) * ld + h * 128 + kc); \
        rv[sb][i] = *(const u32x4*)(P.VT + (size_t)(h * 128 + vr + 64 * i) * T + tb + k0_ + vc); } } \
    if (!SBK) { if (tid < 128) rc = P.CF[bh * SEQ + (2 * (tp) + 1 - (tid >> 6)) * 64 + (tid & 63)]; rcn = P.CF[bh * SEQ + (2 * (tp) + 1) * 64 + 63]; } } while (0)
#define AT_STORE(buf) do { \
    _Pragma("unroll") for (int sb = 0; sb < 2; ++sb) \
      _Pragma("unroll") for (int i = 0; i < 2; ++i) { \
        *(u32x4*)(K_s + ((buf) * 2 + sb) * 8704 + (kr + 32 * i) * 136 + kc) = rk[sb][i]; \
        *(u32x4*)(V_s + ((buf) * 2 + sb) * 9216 + (vr + 64 * i) * 72 + vc) = rv[sb][i]; } \
    if (!SBK && tid < 128) ck_s[((buf) * 2 + (tid >> 6)) * 64 + (tid & 63)] = rc; } while (0)
  const int np2 = qb + 1;
  AT_LOAD(np2 - 1);
  bf16x8 qf[4];
  float zmax = 0.f;
  {
    const bf16_t* qp = P.Q + (size_t)(tb + q) * ld + h * 128 + fq * 8;
    float v[32]; float ss = 0.f;
#pragma unroll
    for (int kk = 0; kk < 4; ++kk) {
      const u32x4 x = *(const u32x4*)(qp + 32 * kk);
      v[kk * 8 + 0] = bflo(x.x); v[kk * 8 + 1] = bfhi(x.x); v[kk * 8 + 2] = bflo(x.y); v[kk * 8 + 3] = bfhi(x.y);
      v[kk * 8 + 4] = bflo(x.z); v[kk * 8 + 5] = bfhi(x.z); v[kk * 8 + 6] = bflo(x.w); v[kk * 8 + 7] = bfhi(x.w);
    }
    float sc = QSCALE;
    float gqm = 0.f, gkm = 0.f;
    if (!SBK) {
#pragma unroll
      for (int e = 0; e < 32; ++e) ss += v[e] * v[e];
      ss += __shfl_xor(ss, 16); ss += __shfl_xor(ss, 32);
      sc = QSCALE * rsqrtf(ss * (1.f / 128.f) + EPS);
    }
#pragma unroll
    for (int kk = 0; kk < 4; ++kk) {
      float g[8];
#pragma unroll
      for (int e = 0; e < 8; ++e) { g[e] = SBK ? 1.f : P.qg[fq * 8 + 32 * kk + e]; if (!SBK) { gqm = fmaxf(gqm, fabsf(g[e])); gkm = fmaxf(gkm, fabsf(P.kg[fq * 8 + 32 * kk + e])); } }
      u32x4 w;
      w.x = pk2(v[kk * 8 + 0] * sc * g[0], v[kk * 8 + 1] * sc * g[1]); w.y = pk2(v[kk * 8 + 2] * sc * g[2], v[kk * 8 + 3] * sc * g[3]);
      w.z = pk2(v[kk * 8 + 4] * sc * g[4], v[kk * 8 + 5] * sc * g[5]); w.w = pk2(v[kk * 8 + 6] * sc * g[6], v[kk * 8 + 7] * sc * g[7]);
      qf[kk] = __builtin_bit_cast(bf16x8, w);
    }
    if (!SBK) {
      gqm = fmaxf(gqm, __shfl_xor(gqm, 16)); gqm = fmaxf(gqm, __shfl_xor(gqm, 32));
      gkm = fmaxf(gkm, __shfl_xor(gkm, 16)); gkm = fmaxf(gkm, __shfl_xor(gkm, 32));
      zmax = 11.3137085f * gqm * gkm * 1.02f + 0.5f;
    }
  }
  AT_STORE(0);
  __syncthreads();
  bool wave_done = false;
  for (int it = 0; it < np2; ++it) {
    const int buf = it & 1;
    if (it > 0) {
      const volatile int* f = dflag + ((it - 1) & 1) * 8;
      if (f[0] & f[1] & f[2] & f[3] & f[4] & f[5] & f[6] & f[7]) break;
    }
    if (it + 1 < np2) AT_LOAD(np2 - 2 - it);
#pragma unroll
    for (int sb = 0; sb < 2; ++sb) {
    const int ti = 2 * (np2 - 1 - it) + 1 - sb; const int k0 = ti * 64; const bool last_tile = (ti == 0);
    if (k0 <= qmax_w && !wave_done) {
      const bf16_t* Kb = K_s + (buf * 2 + sb) * 8704; const bf16_t* Vb = V_s + (buf * 2 + sb) * 9216;
      f32x4 s[4];
#pragma unroll
      for (int kt = 0; kt < 4; ++kt) {
        s[kt] = (f32x4){0.f, 0.f, 0.f, 0.f};
#pragma unroll
        for (int kk = 0; kk < 4; ++kk) s[kt] = MFMA16(*(const bf16x8*)(Kb + (kt * 16 + fr) * 136 + fq * 8 + 32 * kk), qf[kk], s[kt]);
      }
      bf16x8 pf[2];
      if (!SBK) {
        float mx = -INFINITY;
        const bool need_mask = (k0 + 63 > qmin_w);
#pragma unroll
        for (int kt = 0; kt < 4; ++kt) {
          const float4 cv = *(const float4*)(ck_s + (buf * 2 + sb) * 64 + kt * 16 + fq * 4);
          const float cc[4] = {cv.x, cv.y, cv.z, cv.w};
#pragma unroll
          for (int j = 0; j < 4; ++j) { float v = s[kt][j] - cc[j]; if (need_mask) { const int key = k0 + kt * 16 + fq * 4 + j; v = (key <= q) ? v : -INFINITY; } s[kt][j] = v; mx = fmaxf(mx, v); }
        }
        mx = fmaxf(mx, __shfl_xor(mx, 16)); mx = fmaxf(mx, __shfl_xor(mx, 32));
        if (__any(mx > m_run)) {
          const float m_new = fmaxf(m_run, mx);
          const float alpha = __expf(m_run - m_new);
          m_run = m_new;
          l_run *= alpha;
#pragma unroll
          for (int dt = 0; dt < 8; ++dt) acc_o[dt] = acc_o[dt] * alpha;
        }
        float ps = 0.f;
#pragma unroll
        for (int kt = 0; kt < 4; ++kt)
#pragma unroll
          for (int j = 0; j < 4; ++j) { const float p = __expf(s[kt][j] - m_run); s[kt][j] = p; ps += p; }
        l_run += ps;
        if (!last_tile) { const float cnext = (sb == 0) ? ck_s[(buf * 2 + 1) * 64 + 63] : rcn; wave_done = __all(zmax - cnext - m_run < -110.f) != 0; }
      } else {
        float lsig[4][4];
        bf16x8 lf[2];
#pragma unroll
        for (int kt = 0; kt < 4; ++kt)
#pragma unroll
          for (int j = 0; j < 4; ++j) {
            const int key = k0 + kt * 16 + fq * 4 + j; const float z = s[kt][j]; const float sp = softplus_(z);
            lsig[kt][j] = z - sp; s[kt][j] = (key < q) ? -sp : 0.f;
          }
#pragma unroll
        for (int g = 0; g < 2; ++g) { u32x4 w; w.x = pk2(s[2 * g][0], s[2 * g][1]); w.y = pk2(s[2 * g][2], s[2 * g][3]); w.z = pk2(s[2 * g + 1][0], s[2 * g + 1][1]); w.w = pk2(s[2 * g + 1][2], s[2 * g + 1][3]); lf[g] = __builtin_bit_cast(bf16x8, w); }
        f32x4 tl[4], tot;
        const f32x4 zero4 = {0.f, 0.f, 0.f, 0.f};
        tl[0] = MFMA16(Ue, lf[0], zero4); tl[0] = MFMA16(U1, lf[1], tl[0]);
        tl[1] = MFMA16(Uo, lf[0], zero4); tl[1] = MFMA16(U1, lf[1], tl[1]);
        tl[2] = MFMA16(Ue, lf[1], zero4);
        tl[3] = MFMA16(Uo, lf[1], zero4);
        tot = MFMA16(U1, lf[0], zero4); tot = MFMA16(U1, lf[1], tot);
#pragma unroll
        for (int kt = 0; kt < 4; ++kt)
#pragma unroll
          for (int j = 0; j < 4; ++j) { const int key = k0 + kt * 16 + fq * 4 + j; s[kt][j] = (key < q) ? __expf(lsig[kt][j] + tl[kt][j] + R) : 0.f; }
        R += tot[0];
        wave_done = __all(R < -110.f) != 0;
      }
#pragma unroll
      for (int g = 0; g < 2; ++g) { u32x4 w; w.x = pk2(s[2 * g][0], s[2 * g][1]); w.y = pk2(s[2 * g][2], s[2 * g][3]); w.z = pk2(s[2 * g + 1][0], s[2 * g + 1][1]); w.w = pk2(s[2 * g + 1][2], s[2 * g + 1][3]); pf[g] = __builtin_bit_cast(bf16x8, w); }
#pragma unroll
      for (int dt = 0; dt < 8; ++dt)
#pragma unroll
        for (int g = 0; g < 2; ++g) {
          const bf16_t* vp = Vb + (dt * 16 + fr) * 72 + 32 * g + fq * 4;
          u32x4 a; const u32x2 a0 = *(const u32x2*)vp, a1 = *(const u32x2*)(vp + 16);
          a.x = a0.x; a.y = a0.y; a.z = a1.x; a.w = a1.y;
          acc_o[dt] = MFMA16(__builtin_bit_cast(bf16x8, a), pf[g], acc_o[dt]);
        }
    }
    }
    if (it + 1 < np2) AT_STORE(buf ^ 1);
    if (lane == 0) dflag[(it & 1) * 8 + wave] = wave_done ? 1 : 0;
    __syncthreads();
  }
#undef AT_LOAD
#undef AT_STORE
  {
    float inv = 1.f;
    if (!SBK) { float l = l_run; l += __shfl_xor(l, 16); l += __shfl_xor(l, 32); inv = 1.f / l; }
    bf16_t* op = P.O + (size_t)(tb + q) * 1024 + h * 128 + fq * 4;
#pragma unroll
    for (int dt = 0; dt < 8; ++dt) {
      float o0 = acc_o[dt][0] * inv, o1 = acc_o[dt][1] * inv, o2 = acc_o[dt][2] * inv, o3 = acc_o[dt][3] * inv;
      if (!SBK) {
        const u32x2 gv = *(const u32x2*)(P.gate + (size_t)(tb + q) * ld + h * 128 + dt * 16 + fq * 4);
        o0 *= sigmoid_(bflo(gv.x)); o1 *= sigmoid_(bfhi(gv.x)); o2 *= sigmoid_(bflo(gv.y)); o3 *= sigmoid_(bfhi(gv.y));
      }
      u32x2 p; p.x = pk2(o0, o1); p.y = pk2(o2, o3);
      *(u32x2*)(op + dt * 16) = p;
    }
  }
}

__device__ __forceinline__ void fox_knorm(bf16_t* Kb  , const float* kg) {
  const int tid = tid_fresh();
  const int seg = tid & 15;
  float g[8];
#pragma unroll
  for (int e = 0; e < 8; ++e) g[e] = kg[seg * 8 + e];
  const int stride = gridDim.x * 32;
  for (int it0 = blockIdx.x * 32 + (tid >> 4); it0 < T * 4; it0 += stride * 4) {
    u32x4 xs[4];
#pragma unroll
    for (int k = 0; k < 4; ++k) { const int it = it0 + k * stride; const int itc = it < T * 4 ? it : it0; xs[k] = *(const u32x4*)(Kb + (size_t)(itc >> 2) * 3584 + (itc & 3) * 128 + seg * 8); }
#pragma unroll
    for (int k = 0; k < 4; ++k) {
      const int it = it0 + k * stride;
      u32x4 x = xs[k];
      float v[8]; v[0] = bflo(x.x); v[1] = bfhi(x.x); v[2] = bflo(x.y); v[3] = bfhi(x.y); v[4] = bflo(x.z); v[5] = bfhi(x.z); v[6] = bflo(x.w); v[7] = bfhi(x.w);
      float ss = 0.f;
#pragma unroll
      for (int e = 0; e < 8; ++e) ss += v[e] * v[e];
      ss += __shfl_xor(ss, 1); ss += __shfl_xor(ss, 2); ss += __shfl_xor(ss, 4); ss += __shfl_xor(ss, 8);
      const float r = rsqrtf(ss * (1.f / 128.f) + EPS);
      x.x = pk2(v[0] * r * g[0], v[1] * r * g[1]); x.y = pk2(v[2] * r * g[2], v[3] * r * g[3]); x.z = pk2(v[4] * r * g[4], v[5] * r * g[5]); x.w = pk2(v[6] * r * g[6], v[7] * r * g[7]);
      if (it < T * 4) *(u32x4*)(Kb + (size_t)(it >> 2) * 3584 + (it & 3) * 128 + seg * 8) = x;
    }
  }
}

#ifndef NREP_G
#define NREP_G 1
#endif
#ifndef REP_MODE
#define REP_MODE -1
#endif
#ifndef NREP_N
#define NREP_N 1
#endif
#ifndef NREP_P
#define NREP_P 1
#endif
#ifndef NREP_S
#define NREP_S 1
#endif
#ifndef NREP_F
#define NREP_F 1
#endif
#ifndef NREP_B
#define NREP_B 1
#endif


#define WSP(T_, off) ((T_*)(ws + (off)))
#define GRID_BAR() do { XcdBarrier b_; b_.bar = (unsigned*)(fresh_args()->ws + WS_BAR); b_.x = xb_xcc_id(); b_.st = (volatile LAS unsigned*)(glds + 151 * 1024); xcd_barrier(b_); } while (0)

#ifdef DEBUG_NAN
__device__ __forceinline__ void chk_words(const unsigned* p, size_t nwords, bool bf, unsigned* err, unsigned code) {
  bool bad = false, nan = false;
  for (size_t i = ((size_t)blockIdx.x * 512 + threadIdx.x); i < nwords; i += (size_t)gridDim.x * 512) {
    const unsigned w = p[i];
    if ((w & 0x7F800000u) >= (141u << 23)) bad = true;
    if ((w & 0x7F800000u) == 0x7F800000u) nan = true;
    if (bf && (w & 0x7F80u) >= (141u << 7)) bad = true;
    if (bf && (w & 0x7F80u) == 0x7F80u) nan = true;
  }
  if (bad) atomicCAS(err, 0u, code);
  if (nan) atomicCAS(err + 1, 0u, code);
}
#endif

__global__ void __launch_bounds__(512, 2) fwd_megakernel(Args a_unused) {
  extern __shared__ __attribute__((aligned(16))) unsigned char lds[];
  cg::grid_group grid = cg::this_grid();
  PG8_LAS unsigned char* glds = (PG8_LAS unsigned char*)lds;
  const int G = gridDim.x, bid = blockIdx.x;
  if (threadIdx.x < 4) ((volatile LAS unsigned*)(glds + 151 * 1024))[threadIdx.x] = 0u;
  __syncthreads();
  (void)xcd_barrier_post((unsigned*)(fresh_args()->ws + WS_BAR), (volatile LAS unsigned*)(glds + 151 * 1024));
  grid.sync();

  for (int step = 0; step < 8; ++step) {
    const int l = step >> 1, which = step & 1, j = l >> 1; const bool even = (l & 1) == 0;
    const int np = which ? 3 : 10;
    const int nmain = even ? 3584 : 2048, nv = even ? 512 : 1024;
    for (int p = 0; p < np; ++p) {
      if ((p == 6 || p == 8) && !even) continue;
      if (p == 3 || (p == 0 && which == 1)) continue;
      if (p == 1 || p == 2 || p == 4 || p == 5 || p == 9) {
        ArgsP a = fresh_args(); unsigned char* ws = a->ws;
        const bf16_t* gA; const bf16_t* gB; int gM, gN, gK, emode, eldc; void* eP; float escale; int oid = bid;
        if (p == 1) { gA = WSP(bf16_t, WS_XN); gB = which ? WSP(bf16_t, WS_GU2) : WSP(bf16_t, WS_GU1); gM = T; gN = 5632; gK = 1024; emode = 0; eP = WSP(void, WS_BIG); eldc = FF; escale = 0.f; }
        else if (p == 2) { gA = WSP(bf16_t, WS_BIG); gB = which ? WSP(bf16_t, WS_DN2) : WSP(bf16_t, WS_DN1); gM = T; gN = 1024; gK = FF; emode = 1; eP = a->out; eldc = 1024; escale = 0.5f; }
        else if (p == 4) { gA = WSP(bf16_t, WS_XN); gB = WSP(bf16_t, WS_WIN); gM = T; gN = nmain; gK = 1024; emode = 2; eP = WSP(void, WS_BIG); eldc = nmain; escale = 0.f;
                           if (even) norm_phase<true>(lds, a->out, nullptr, a->in[4] + l * 1024, nullptr, a->in[5] + (size_t)j * 1024 * 4108, a->in[7] + j * 4, a->in[8] + j * 4, a->in[12] + j * 4, WSP(float, WS_SM)); }
        else if (p == 5) { gA = WSP(bf16_t, WS_WIN) + (size_t)nmain * 1024; gB = WSP(bf16_t, WS_XN); gM = nv; gN = T; gK = 1024; emode = 3; eP = WSP(void, WS_VT); eldc = T; escale = 0.f; if (even) oid = (bid + G / 2) % G; }
        else { gA = WSP(bf16_t, WS_OB); gB = WSP(bf16_t, WS_WOUT); gM = T; gN = 1024; gK = 1024; emode = 1; eP = a->out; eldc = 1024; escale = 1.0f; }
        const pg8::Gemm g{gA, gB, gM, gN, gK};
        const EpiAny E{emode, eP, eldc, escale};
        pg8::StaticOrder S; S.init(g.M, g.N, G, oid);
#ifndef NO_G
#if NREP_G > 1
        for (int rep = 0; rep < ((REP_MODE < 0 || emode == REP_MODE) ? NREP_G : 1); ++rep) { EpiAny Er = E; if (rep + 1 < ((REP_MODE < 0 || emode == REP_MODE) ? NREP_G : 1)) Er.scale = 0.f; pg8::gemm_phase<EpiAny, pg8::StaticOrder>(glds, g, S, Er, nullptr); }
#else
        pg8::gemm_phase<EpiAny, pg8::StaticOrder>(glds, g, S, E, nullptr);
#endif
#endif
        if (p == 4) continue;
      } else if (p == 0) {
        for (int rep = 0; rep < NREP_N; ++rep) {
        ArgsP a = fresh_args(); unsigned char* ws = a->ws;
        convert_layer((float*)lds, even, l, j, a, ws);
        if (step == 0) init_phase(a->in[0], a->out, WSP(bf16_t, WS_XN), WSP(float, WS_PS));
        }
      } else if (p == 6) {
#ifndef NO_PREP
        ArgsP a = fresh_args(); unsigned char* ws = a->ws;
        cumsum_logf(lds, WSP(float, WS_SM), WSP(float, WS_CF));
        fox_knorm(WSP(bf16_t, WS_BIG) + 2560, a->in[11] + j * 128);
        for (int rep = 0; rep < NREP_P; ++rep) for (int u = bid; u < 1024; u += G) dn_prep_unit(lds, u, WSP(bf16_t, WS_BIG), WSP(float, WS_SM), a->in[6] + (size_t)j * 4 * 1536, ws + WS_DNX, WSP(float, WS_GL));
#endif
      } else if (p == 8) {
        ArgsP a = fresh_args(); unsigned char* ws = a->ws;
        dn_fixup(WSP(float, WS_OF), WSP(float, WS_PSD), WSP(bf16_t, WS_BIG), a->in[9] + j * 128, WSP(bf16_t, WS_OB));
      } else if (p == 7) {
        if (even) {
#ifndef NO_SCAN
          if (bid < 64) for (int rep = 0; rep < NREP_S; ++rep) { ArgsP a = fresh_args(); unsigned char* ws = a->ws; dn_scan(lds, bid, ws + WS_DNX, WSP(float, WS_GL), WSP(float, WS_OF), WSP(float, WS_PSD)); }
#endif
          ArgsP a = fresh_args(); unsigned char* ws = a->ws;
          int* qslot = (int*)(lds + 150 * 1024);
          AttnP P; P.Q = WSP(bf16_t, WS_BIG) + 2048; P.K = WSP(bf16_t, WS_BIG) + 2560; P.ld = 3584; P.VT = WSP(bf16_t, WS_VT); P.qg = a->in[10] + j * 128; P.kg = a->in[11] + j * 128;
          P.CF = WSP(float, WS_CF); P.gate = WSP(bf16_t, WS_BIG) + 3072; P.O = WSP(bf16_t, WS_OB) + 512; P.H = 4;
          for (int rep = 0; rep < NREP_F; ++rep) {
          unsigned* ctr = WSP(unsigned, WS_CTL) + l + 8 * rep;
          for (;;) {
            if (threadIdx.x == 0) *qslot = (int)atomicAdd(ctr, 1u);
            __syncthreads();
            const int unit = *qslot;
            __syncthreads();
            if (unit >= 512) break;
#ifndef NO_FOX
            attn_unit<false>(lds, P, unit & 15, 31 - (unit >> 4));
#endif
          }
          }
        } else {
          ArgsP a = fresh_args(); unsigned char* ws = a->ws;
          int* qslot = (int*)(lds + 150 * 1024);
          AttnP P; P.Q = WSP(bf16_t, WS_BIG); P.K = WSP(bf16_t, WS_BIG) + 1024; P.ld = 2048; P.VT = WSP(bf16_t, WS_VT); P.qg = nullptr; P.kg = nullptr; P.CF = nullptr; P.gate = nullptr; P.O = WSP(bf16_t, WS_OB); P.H = 8;
          for (int rep = 0; rep < NREP_B; ++rep) {
          unsigned* ctr = WSP(unsigned, WS_CTL) + l + 8 * rep;
          for (;;) {
            if (threadIdx.x == 0) *qslot = (int)atomicAdd(ctr, 1u);
            __syncthreads();
            const int unit = *qslot;
            __syncthreads();
            if (unit >= 1024) break;
#ifndef NO_SB
            attn_unit<true>(lds, P, unit & 31, 31 - (unit >> 5));
#endif
          }
          }
        }
      }
      GRID_BAR();
#ifdef NREP_Y
      GRID_BAR();
#endif
#ifdef DEBUG_NAN
      {
        ArgsP a = fresh_args(); unsigned* err = (unsigned*)(a->ws + WS_CTL) + 64; const unsigned code = (unsigned)(step * 10 + p + 1);
        const unsigned* cp = nullptr; size_t nw = 0; bool bf = true;
        if (p == 0 || p == 3) { cp = (const unsigned*)(a->ws + WS_XN); nw = (size_t)T * 512; }
        if (p == 1) { cp = (const unsigned*)(a->ws + WS_BIG); nw = (size_t)T * FF / 2; }
        if (p == 2 || p == 8) { cp = (const unsigned*)a->out; nw = (size_t)T * 1024; bf = false; }
        if (p == 5) { cp = (const unsigned*)(a->ws + WS_BIG); nw = (size_t)T * nmain / 2; }
        if (p == 6) { cp = (const unsigned*)(a->ws + WS_DNX); nw = (size_t)1024 * DNX_UNIT / 4; }
        if (p == 7) { cp = (const unsigned*)(a->ws + WS_OB); nw = (size_t)T * 512; }
        chk_words(cp, nw, bf, err, code);
        if (p == 5) chk_words((const unsigned*)(a->ws + WS_VT), (size_t)T * nv / 2, true, err, 90u + (unsigned)step);
      }
#endif
    }
  }
#ifdef DEBUG_NAN
  {
    ArgsP a = fresh_args(); float* X = a->out; const unsigned err = *((volatile unsigned*)(a->ws + WS_CTL) + 64), errn = *((volatile unsigned*)(a->ws + WS_CTL) + 65);
    for (size_t i = ((size_t)blockIdx.x * 512 + threadIdx.x); i < (size_t)T * 1024; i += (size_t)gridDim.x * 512) {
      X[i] = (i == 5 && (err | errn)) ? (errn ? 100.f * (float)errn : (float)err) : 0.f;
    }
  }
#endif
}

extern "C" void kernel_launch(void* const* d_in, const int* in_sizes, int n_in,
                              void* d_out, int out_size, void* d_ws, size_t ws_size,
                              hipStream_t stream) {
  static int grid = 0;
  if (grid == 0) {
    int dev = 0, cus = 0, per_cu = 0;
    (void)hipGetDevice(&dev);
    (void)hipDeviceGetAttribute(&cus, hipDeviceAttributeMultiprocessorCount, dev);
    (void)hipFuncSetAttribute((const void*)fwd_megakernel, hipFuncAttributeMaxDynamicSharedMemorySize, LDS_BYTES);
    (void)hipOccupancyMaxActiveBlocksPerMultiprocessor(&per_cu, (const void*)fwd_megakernel, 512, LDS_BYTES);
    (void)hipGetLastError();
    grid = cus > 0 ? cus : 256;
    if (ws_size < WS_END || n_in != 19) { fprintf(stderr, "kernel_launch: ws %zu < %zu or n_in %d\n", ws_size, (size_t)WS_END, n_in); grid = -1; }
    fprintf(stderr, "kernel_launch: cus %d per_cu %d grid %d ws %zu need %zu\n", cus, per_cu, grid, ws_size, (size_t)WS_END);
  }
  if (grid < 0) return;
  (void)hipMemsetAsync((char*)d_ws + WS_CTL, 0, CTL_BYTES, stream);
  Args a{};
  for (int i = 0; i < 19; ++i) a.in[i] = (const float*)d_in[i];
  a.out = (float*)d_out; a.ws = (unsigned char*)d_ws;
  void* args[] = {&a};
  hipError_t e = hipLaunchCooperativeKernel((const void*)fwd_megakernel, dim3(grid), dim3(512), args, LDS_BYTES, stream);
  if (e != hipSuccess) fprintf(stderr, "cooperative launch failed: %s (grid %d)\n", hipGetErrorString(e), grid);
}
```

```cpp
#include <hip/hip_runtime.h>
#include <hip/hip_cooperative_groups.h>
#include <cstdio>
namespace cg = cooperative_groups;
__device__ __forceinline__ int tid_fresh() { int t = threadIdx.x; asm volatile("" : "+v"(t)); return t; }
namespace pg8 {
#define PG8_LAS __attribute__((address_space(3)))
typedef unsigned short bf16_t;
typedef short bf16x8 __attribute__((ext_vector_type(8)));
typedef float f32x4 __attribute__((ext_vector_type(4)));
typedef unsigned u32x4 __attribute__((ext_vector_type(4)));
constexpr int BM = 256, BK = 64, HALF = 128, HTB = HALF * BK * 2  , STAGE_BYTES = 8 * HTB, NXCD = 8, WGM = 8;

__host__ __device__ __forceinline__ int lds_byte(int r, int c) { const int st = (r >> 4) * 2 + (c >> 5), rr = r & 15, cc = c & 31, ob = rr * 64 + cc * 2; return st * 1024 + (ob ^ (((ob >> 9) & 1) << 5)); }
__host__ __device__ __forceinline__ void stage_rc(int b, int& R, int& C) { const int st = b / 1024, sb = b % 1024, swz = sb ^ (((sb >> 9) & 1) << 5); R = (st >> 1) * 16 + swz / 64; C = (st & 1) * 32 + (swz % 64) / 2; }
__host__ __device__ __forceinline__ int perm32(int rho) { const int n = rho >> 4, i = rho & 15; return 8 * (i >> 2) + 4 * n + (i & 3); }

struct Unit { int pm, pn; };
struct Gemm { const bf16_t* A; const bf16_t* Bt; int M, N, K; };

struct StaticOrder {
    int nM, nN, nwg, G, c;
    __host__ __device__ void init(int M, int N, int G_, int c_) { nM = M / BM; nN = N / BM; nwg = nM * nN; G = G_; c = c_; }
    __host__ __device__ bool next(int i, Unit& u) const {
        const long L = (long)i * G + c; if (L >= nwg) return false;
        int wgid = (int)L; { const int q = nwg / NXCD, r = nwg % NXCD, xcd = wgid % NXCD, off = wgid / NXCD; wgid = (xcd < r ? xcd * (q + 1) : r * (q + 1) + (xcd - r) * q) + off; }
        const int nig = WGM * nN, gid = wgid / nig, fm = gid * WGM, gsz = (nM - fm) < WGM ? (nM - fm) : WGM;
        u.pm = fm + ((wgid % nig) % gsz); u.pn = (wgid % nig) / gsz; return true;
    }
    __device__ __forceinline__ void a_ready(const Unit&) const {}
    __device__ __forceinline__ void done(const Unit&) const {}
};
struct CountedOrder : StaticOrder {
    const unsigned* ready; unsigned need; unsigned* tmo;
    __device__ __forceinline__ void a_ready(const Unit& u) const {
        if (threadIdx.x < 64) {
            const unsigned long long t0 = __builtin_amdgcn_s_memrealtime(); unsigned polls = 0;
            while ((unsigned)__builtin_amdgcn_readfirstlane(__hip_atomic_load(ready + 64 * u.pm, __ATOMIC_RELAXED, __HIP_MEMORY_SCOPE_AGENT)) < need) {
                if ((++polls & 255u) == 0u && __builtin_amdgcn_readfirstlane(__hip_atomic_load(tmo, __ATOMIC_RELAXED, __HIP_MEMORY_SCOPE_AGENT)) != 0u) break;
                if (__builtin_amdgcn_s_memrealtime() - t0 > 2000000ull) {
                    if (threadIdx.x == 0) { unsigned expect = 0u; __hip_atomic_compare_exchange_strong(tmo + 1, &expect, 0x600u | (unsigned)(u.pm & 0xff), __ATOMIC_RELAXED, __ATOMIC_RELAXED, __HIP_MEMORY_SCOPE_AGENT); __hip_atomic_store(tmo, 1u, __ATOMIC_RELAXED, __HIP_MEMORY_SCOPE_AGENT); }
                    break; }
                __builtin_amdgcn_s_sleep(2); }
            __builtin_amdgcn_fence(__ATOMIC_ACQUIRE, "agent");
            asm volatile("s_waitcnt vmcnt(0)" ::: "memory");
        }
#if !defined(BROKEN_HOOK_NO_BARRIER)
        asm volatile("" ::: "memory"); __builtin_amdgcn_s_barrier(); asm volatile("" ::: "memory");
#endif
    }
};

__device__ __forceinline__ unsigned cvt_pk_bf16(float lo, float hi) { unsigned r; asm volatile("v_cvt_pk_bf16_f32 %0, %1, %2" : "=v"(r) : "v"(lo), "v"(hi)); return r; }

template <class Epi, class Sched, bool STAMP = false>
__device__ __forceinline__ void gemm_phase(PG8_LAS unsigned char* lds, const Gemm g, const Sched& S, const Epi& E, unsigned long long* stamps) {
    const int tid = tid_fresh(), wid = __builtin_amdgcn_readfirstlane(tid >> 6), lane = tid & 63, wr = wid >> 2, wc = wid & 3, fr = lane & 15, fq = lane >> 4;
    const int K = g.K, nt = K / BK;
    int ts_lo = 0, ts_hi = 0, nts = 0; const unsigned long long rt_entry = STAMP ? (unsigned long long)wall_clock64() : 0ull;
#define PG8_STAMP() do { if (STAMP && wid == 0 && nts < 64) { const unsigned long long _c = (unsigned long long)clock64(); \
        ts_lo = (lane == nts) ? (int)(unsigned)_c : ts_lo; ts_hi = (lane == nts) ? (int)(unsigned)(_c >> 32) : ts_hi; ++nts; } } while (0)
    PG8_STAMP();
    unsigned voffA[2], voffB[2];
#pragma unroll
    for (int i = 0; i < 2; ++i) { int R, C; stage_rc(tid * 16 + i * 8192, R, C); const int Rb = E.perm() ? ((R & ~31) + perm32(R & 31)) : R;
        voffA[i] = (unsigned)(R * K + C) * 2u; voffB[i] = (unsigned)(Rb * K + C) * 2u; }
    const size_t kstep = (size_t)(BK * 2);
    const size_t hstep = (size_t)HALF * K * 2;
    const size_t tstep = 2 * hstep;
    const unsigned ldsw = (unsigned)wid * 1024u;
    const int aoff = lds_byte(wr * 64 + fr, fq * 8), boff = lds_byte(wc * 32 + fr, fq * 8);
#define PG8_SA(b, h) (((b) * 2 + (h)) * HTB)
#define PG8_SB(b, h) ((4 + (b) * 2 + (h)) * HTB)
#define PG8_STAGE(bufoff, gbase, voff) do { _Pragma("unroll") for (int _i = 0; _i < 2; ++_i) \
        __builtin_amdgcn_global_load_lds((const unsigned*)((const char*)(gbase) + (voff)[_i]), (PG8_LAS unsigned*)(lds + (bufoff) + ldsw + _i * 8192), 16, 0, 0); } while (0)
#define PG8_LDA(dst, b, h) do { _Pragma("unroll") for (int m = 0; m < 4; ++m) _Pragma("unroll") for (int k = 0; k < 2; ++k) dst[m][k] = *(const PG8_LAS bf16x8*)(lds + PG8_SA(b, h) + aoff + m * 2048 + k * 1024); } while (0)
#define PG8_LDB(dst, b, h) do { _Pragma("unroll") for (int n = 0; n < 2; ++n) _Pragma("unroll") for (int k = 0; k < 2; ++k) dst[n][k] = *(const PG8_LAS bf16x8*)(lds + PG8_SB(b, h) + boff + n * 2048 + k * 1024); } while (0)
#define PG8_MMA(ai, bj, At, Bt) do { __builtin_amdgcn_s_setprio(1); _Pragma("unroll") for (int m = 0; m < 4; ++m) _Pragma("unroll") for (int n = 0; n < 2; ++n) _Pragma("unroll") for (int k = 0; k < 2; ++k) \
        acc[ai][bj][m][n] = __builtin_amdgcn_mfma_f32_16x16x32_bf16(Bt[n][k], At[m][k], acc[ai][bj][m][n], 0, 0, 0); __builtin_amdgcn_s_setprio(0); } while (0)
#define PG8_WAIT_V(n) asm volatile("s_waitcnt vmcnt(" #n ")" ::: "memory")
#define PG8_WAIT_L(n) asm volatile("s_waitcnt lgkmcnt(" #n ")" ::: "memory")
#define PG8_BAR __builtin_amdgcn_s_barrier()
#define PG8_SCHED __builtin_amdgcn_sched_barrier(0)
    Unit cur, nxt; int ui = 0;
    if (!S.next(0, cur)) return;
    f32x4 acc[2][2][4][2];
    E.init(acc, cur, wr, wc, fr, fq);
    bf16x8 At[4][2], B0[2][2], B1[2][2];
    const char* cA = (const char*)g.A + (size_t)cur.pm * tstep; const char* cB = (const char*)g.Bt + (size_t)cur.pn * tstep;
    S.a_ready(cur);
    PG8_STAGE(PG8_SB(0, 0), cB, voffB); PG8_STAGE(PG8_SA(0, 0), cA, voffA); PG8_STAGE(PG8_SB(0, 1), cB + hstep, voffB); PG8_STAGE(PG8_SA(0, 1), cA + hstep, voffA);
    E.prepare(S, tid);
    if (wr == 1) PG8_BAR;
    PG8_WAIT_V(4); PG8_BAR;
    PG8_STAGE(PG8_SB(1, 0), cB + kstep, voffB); PG8_STAGE(PG8_SA(1, 0), cA + kstep, voffA); PG8_STAGE(PG8_SB(1, 1), cB + hstep + kstep, voffB);
    PG8_WAIT_V(6); PG8_BAR;
    PG8_STAMP();
    for (;;) {
        const bool has_next = S.next(ui + 1, nxt);
        const char* nA = has_next ? (const char*)g.A + (size_t)nxt.pm * tstep : cA; const char* nB = has_next ? (const char*)g.Bt + (size_t)nxt.pn * tstep : cB;
        for (int t = 0; t < nt; t += 2) {
            const bool last = (t == nt - 2);
            const char* a1 = cA + (size_t)(t + 1) * kstep;
            const char* a2 = last ? nA : cA + (size_t)(t + 2) * kstep; const char* b2 = last ? nB : cB + (size_t)(t + 2) * kstep;
            const char* a3 = a2 + kstep; const char* b3 = b2 + kstep;
            if (last && has_next) S.a_ready(nxt);
            PG8_LDB(B0, 0, 0); PG8_SCHED; PG8_LDA(At, 0, 0); PG8_STAGE(PG8_SA(1, 1), a1 + hstep, voffA);
            PG8_WAIT_L(8); PG8_BAR; PG8_WAIT_L(0); PG8_MMA(0, 0, At, B0); PG8_BAR; PG8_SCHED;
            PG8_LDB(B1, 0, 1); PG8_STAGE(PG8_SB(0, 0), b2, voffB);
            PG8_BAR; PG8_WAIT_L(0); PG8_MMA(0, 1, At, B1); PG8_BAR;
            PG8_LDA(At, 0, 1); PG8_STAGE(PG8_SA(0, 0), a2, voffA);
            PG8_BAR; PG8_WAIT_L(0); PG8_MMA(1, 0, At, B0); PG8_BAR; PG8_SCHED;
            PG8_STAGE(PG8_SB(0, 1), b2 + hstep, voffB);
            PG8_WAIT_V(6); PG8_BAR; PG8_MMA(1, 1, At, B1); PG8_BAR;
            PG8_LDB(B0, 1, 0); PG8_SCHED; PG8_LDA(At, 1, 0); PG8_STAGE(PG8_SA(0, 1), a2 + hstep, voffA);
            PG8_WAIT_L(8); PG8_BAR; PG8_WAIT_L(0); PG8_MMA(0, 0, At, B0); PG8_BAR; PG8_SCHED;
            PG8_LDB(B1, 1, 1); PG8_STAGE(PG8_SB(1, 0), b3, voffB);
            PG8_BAR; PG8_WAIT_L(0); PG8_MMA(0, 1, At, B1); PG8_BAR;
            PG8_LDA(At, 1, 1); PG8_STAGE(PG8_SA(1, 0), a3, voffA);
            PG8_BAR; PG8_WAIT_L(0); PG8_MMA(1, 0, At, B0); PG8_BAR; PG8_SCHED;
            PG8_STAGE(PG8_SB(1, 1), b3 + hstep, voffB);
            PG8_WAIT_V(6); PG8_BAR; PG8_MMA(1, 1, At, B1); PG8_BAR;
        }
        PG8_STAMP();
        if constexpr (!Epi::AFTER_DRAIN) { E(acc, cur, wr, wc, fr, fq, ui);
#ifdef NREP_E
            if (E.perm()) E(acc, cur, wr, wc, fr, fq, ui);
#endif
            S.done(cur); }
        PG8_STAMP();
        if (!has_next) break;
        E.init(acc, nxt, wr, wc, fr, fq);
        cur = nxt; cA = nA; cB = nB; ++ui;
    }
    PG8_WAIT_V(0);
    if (wr == 0) PG8_BAR;
    PG8_BAR;
    if constexpr (Epi::AFTER_DRAIN) { E.fused(acc, cur, wr, wc, fr, fq, lds, wid, lane); S.done(cur); }
    PG8_STAMP();
    if (STAMP && wid == 0) { stamps[lane] = lane < nts ? (((unsigned long long)(unsigned)ts_hi << 32) | (unsigned)ts_lo) : 0ull;
        if (lane == 62) stamps[62] = rt_entry; if (lane == 63) stamps[63] = (unsigned long long)wall_clock64(); }
#undef PG8_STAMP
#undef PG8_SA
#undef PG8_SB
#undef PG8_STAGE
#undef PG8_LDA
#undef PG8_LDB
#undef PG8_MMA
#undef PG8_WAIT_V
#undef PG8_WAIT_L
#undef PG8_BAR
#undef PG8_SCHED
}
}
#define XB_TMO      128
#define XB_XCNT(j)  (256  + 64 * (j))
#define XB_XSUB(j)  (1280 + 64 * (j))
#define XB_XGEN(j)  (2304 + 64 * (j))
#define XB_TOP      3328
#define XB_TOPGEN   3392
#define XCD_BAR_WORDS 3456
#define XB_SPIN_CAP (1u << 18)
#ifndef LAS
#define LAS __attribute__((address_space(3)))
#endif

__device__ __forceinline__ unsigned xb_ld(unsigned* p)              { return __hip_atomic_load(p, __ATOMIC_RELAXED, __HIP_MEMORY_SCOPE_AGENT); }
__device__ __forceinline__ unsigned xb_add(unsigned* p, unsigned v) { return __hip_atomic_fetch_add(p, v, __ATOMIC_RELAXED, __HIP_MEMORY_SCOPE_AGENT); }
__device__ __forceinline__ unsigned xb_xcc_id() { return (unsigned)__builtin_amdgcn_s_getreg((3 << 11) | 20) & 0xFu; }
#define XB_SPIN(cond, bar) do { unsigned _sp = 0; while (cond) { __builtin_amdgcn_s_sleep(1); \
    if ((++_sp & 255u) == 0u) { if (xb_ld(&(bar)[XB_TMO])) break; if (_sp > XB_SPIN_CAP) { atomicAdd(&(bar)[XB_TMO], 1u); break; } } } } while (0)

struct XcdBarrier {
    unsigned* bar; unsigned x;
    volatile LAS unsigned* st;
};

__device__ __forceinline__ XcdBarrier xcd_barrier_post(unsigned* bar, volatile LAS unsigned* st) {
    XcdBarrier b; b.bar = bar; b.x = xb_xcc_id(); b.st = st;
    if (threadIdx.x == 0) (void)xb_add(&bar[XB_XCNT(b.x)], 1u);
    return b;
}
__device__ __forceinline__ void xcd_barrier_complete(unsigned* bar, unsigned x, unsigned& nloc, unsigned& nx) {
    const unsigned G = gridDim.x * gridDim.y * gridDim.z;
    unsigned sum, cnt, mine, sp = 0u;
    for (;;) {
        sum = 0u; cnt = 0u; mine = 0u;
#pragma unroll
        for (unsigned j = 0; j < 16; ++j) { const unsigned c = xb_ld(&bar[XB_XCNT(j)]); sum += c; cnt += (c > 0u) ? 1u : 0u; mine = (j == x) ? c : mine; }
        if (sum == G) break;
        __builtin_amdgcn_s_sleep(1);
        if ((++sp & 255u) == 0u) { if (xb_ld(&bar[XB_TMO])) break; if (sp > XB_SPIN_CAP) { atomicAdd(&bar[XB_TMO], 1u); break; } }
    }
    nloc = mine > 0u ? mine : 1u; nx = cnt > 0u ? cnt : 1u;
}

__device__ __forceinline__ void xcd_barrier(const XcdBarrier& b) {
    asm volatile("s_waitcnt vmcnt(0)" ::: "memory");
    __syncthreads();
    if (threadIdx.x == 0) {
        unsigned* bar = b.bar;
        __builtin_amdgcn_s_waitcnt(0);
        unsigned nloc = b.st[0], nx = b.st[1];
        if (nloc == 0u) { xcd_barrier_complete(bar, b.x, nloc, nx); b.st[0] = nloc; b.st[1] = nx; }
        const unsigned old = xb_add(&bar[XB_XSUB(b.x)], 1u);
        const unsigned gen = old / nloc;
        if (old + 1u == (gen + 1u) * nloc) {
            __builtin_amdgcn_fence(__ATOMIC_RELEASE, "agent");
            asm volatile("s_waitcnt vmcnt(0)" ::: "memory");
            const unsigned og = xb_add(&bar[XB_TOP], 1u);
            const unsigned tg = og / nx;
            if (og + 1u == (tg + 1u) * nx) xb_add(&bar[XB_TOPGEN], 1u);
            else XB_SPIN(xb_ld(&bar[XB_TOPGEN]) == tg, bar);
            __builtin_amdgcn_fence(__ATOMIC_ACQUIRE, "agent");
            xb_add(&bar[XB_XGEN(b.x)], 1u);
            asm volatile("s_waitcnt vmcnt(0)" ::: "memory");
        } else {
            XB_SPIN(xb_ld(&bar[XB_XGEN(b.x)]) == gen, bar);
            __builtin_amdgcn_fence(__ATOMIC_ACQUIRE, "agent");
            asm volatile("s_waitcnt vmcnt(0)" ::: "memory");
        }
    }
    __syncthreads();
}


using pg8::bf16_t; using pg8::bf16x8; using pg8::f32x4; using pg8::u32x4;
typedef unsigned u32x2 __attribute__((ext_vector_type(2)));

constexpr int T = 16384, DM = 1024, FF = 2816, SEQ = 4096;
constexpr float EPS = 1e-6f;
constexpr float QSCALE = 0.08838834764831845f;

constexpr size_t SZ_GU = (size_t)5632 * 1024 * 2, SZ_DN = (size_t)1024 * 2816 * 2;
constexpr size_t WS_CTL = 0;
constexpr size_t WS_BAR = 4096;
constexpr size_t CTL_BYTES = 32768;
constexpr size_t WS_GU1 = CTL_BYTES;
constexpr size_t WS_DN1 = WS_GU1 + SZ_GU;
constexpr size_t WS_GU2 = WS_DN1 + SZ_DN;
constexpr size_t WS_DN2 = WS_GU2 + SZ_GU;
constexpr size_t WS_WIN = WS_DN2 + SZ_DN;
constexpr size_t WS_WOUT = WS_WIN + (size_t)4096 * 1024 * 2;
constexpr size_t WS_XN = WS_WOUT + (size_t)1024 * 1024 * 2;
constexpr size_t WS_BIG = WS_XN + (size_t)T * 1024 * 2;
constexpr size_t WS_VT = WS_BIG + (size_t)T * 3584 * 2;
constexpr size_t WS_OB = WS_VT + (size_t)1024 * T * 2;
constexpr size_t WS_SM = WS_OB + (size_t)T * 1024 * 2;
constexpr size_t WS_CF = WS_SM + (size_t)T * 16 * 4;
constexpr size_t WS_GL = WS_CF + (size_t)16 * 4096 * 4;
constexpr size_t WS_DNX = WS_GL + 4096;
constexpr size_t DNX_UNIT = 73728;
constexpr size_t WS_OF = WS_DNX + 1024 * DNX_UNIT;
constexpr size_t WS_PSD = WS_OF + (size_t)T * 512 * 4;
constexpr size_t WS_PS = WS_PSD + (size_t)T * 16 * 4;
constexpr size_t WS_END = WS_PS + (size_t)T * 16 * 4;
constexpr int LDS_BYTES = 152 * 1024;
constexpr int RS_TAB_OFF = 128 * 1024;

__device__ __forceinline__ float bf2f(unsigned short b) { return __uint_as_float(((unsigned)b) << 16); }
__device__ __forceinline__ float bflo(unsigned w) { return __uint_as_float(w << 16); }
__device__ __forceinline__ float bfhi(unsigned w) { return __uint_as_float(w & 0xffff0000u); }
typedef __bf16 bf16v2_t __attribute__((ext_vector_type(2)));
typedef float f32v2_t __attribute__((ext_vector_type(2)));
__device__ __forceinline__ unsigned pk2(float lo, float hi) { const f32v2_t f = {lo, hi}; const bf16v2_t v = __builtin_convertvector(f, bf16v2_t); return __builtin_bit_cast(unsigned, v); }
__device__ __forceinline__ float fast_rcp(float x) { return __builtin_amdgcn_rcpf(x); }
__device__ __forceinline__ float sigmoid_(float x) { return fast_rcp(1.f + __expf(-x)); }
__device__ __forceinline__ float silu_(float x) { return x * sigmoid_(x); }
__device__ __forceinline__ float softplus_(float x) { return fmaxf(x, 0.f) + __logf(1.f + __expf(-fabsf(x))); }
__device__ __forceinline__ float wave_sum(float v) {
#pragma unroll
  for (int o = 32; o; o >>= 1) v += __shfl_xor(v, o);
  return v;
}

struct Args { const float* in[19]; float* out; unsigned char* ws; };
typedef const __attribute__((address_space(4))) Args* ArgsP;
__device__ __forceinline__ ArgsP fresh_args() { auto p = __builtin_amdgcn_kernarg_segment_ptr(); asm volatile("" : "+s"(p)); return (ArgsP)p; }

__device__ __forceinline__ float rstd_of(const float* PS, int row) {
  const float4 a = *(const float4*)(PS + (size_t)row * 16), b = *(const float4*)(PS + (size_t)row * 16 + 4), c = *(const float4*)(PS + (size_t)row * 16 + 8), d = *(const float4*)(PS + (size_t)row * 16 + 12);
  const float s = ((a.x + a.y) + (a.z + a.w)) + ((b.x + b.y) + (b.z + b.w)) + ((c.x + c.y) + (c.z + c.w)) + ((d.x + d.y) + (d.z + d.w));
  return rsqrtf(s * (1.f / 1024.f) + EPS);
}
struct EpiAny {
  static constexpr bool AFTER_DRAIN = false;
  int mode; void* P; int ldc; float scale;
  __device__ __forceinline__ bool perm() const { return mode != 1; }
  template <class Sched> __device__ __forceinline__ void prepare(const Sched& S, int tid) const {
    if (mode == 1) return;
    extern __shared__ __attribute__((aligned(16))) unsigned char lds_ep[];
    const float* PSg = (const float*)(fresh_args()->ws + WS_PS); float* tab = (float*)(lds_ep + RS_TAB_OFF);
    const int th = __builtin_amdgcn_readfirstlane(tid >> 8), tr = tid & 255;
    float4 pv[3][4]; bool ok[3];
#pragma unroll
    for (int ps = 0; ps < 3; ++ps) {
      pg8::Unit uu; ok[ps] = S.next(ps * 2 + th, uu);
      const float* pp = PSg + (size_t)((mode == 3 ? uu.pn : uu.pm) * 256 + tr) * 16;
#pragma unroll
      for (int k = 0; k < 4; ++k) pv[ps][k] = ok[ps] ? *(const float4*)(pp + 4 * k) : make_float4(0.f, 0.f, 0.f, 0.f);
    }
#pragma unroll
    for (int ps = 0; ps < 3; ++ps) {
      float s = 0.f;
#pragma unroll
      for (int k = 0; k < 4; ++k) s += (pv[ps][k].x + pv[ps][k].y) + (pv[ps][k].z + pv[ps][k].w);
      if (ok[ps]) tab[(ps * 2 + th) * 256 + tr] = rsqrtf(s * (1.f / 1024.f) + EPS);
    }
  }
  __device__ __forceinline__ void init(f32x4 (&acc)[2][2][4][2], const pg8::Unit& u, int wr, int wc, int fr, int fq) const {
    if (mode == 1) {
      const float* X = (const float*)P; const float inv = 1.f / scale;
      const int row0 = u.pm * 256 + wr * 64 + fr, col0 = u.pn * 256 + wc * 32 + 4 * fq;
#pragma unroll
      for (int ai = 0; ai < 2; ++ai)
#pragma unroll
        for (int m = 0; m < 4; ++m)
#pragma unroll
          for (int bj = 0; bj < 2; ++bj)
#pragma unroll
            for (int n = 0; n < 2; ++n) acc[ai][bj][m][n] = *(const f32x4*)(X + (size_t)(row0 + ai * 128 + m * 16) * ldc + col0 + bj * 128 + n * 16) * inv;
    } else {
#pragma unroll
      for (int ai = 0; ai < 2; ++ai)
#pragma unroll
        for (int m = 0; m < 4; ++m)
#pragma unroll
          for (int bj = 0; bj < 2; ++bj)
#pragma unroll
            for (int n = 0; n < 2; ++n) acc[ai][bj][m][n] = (f32x4){0.f, 0.f, 0.f, 0.f};
    }
  }
  __device__ __forceinline__ void operator()(const f32x4 (&acc)[2][2][4][2], const pg8::Unit& u, int wr, int wc, int fr, int fq, int ui) const {
    extern __shared__ __attribute__((aligned(16))) unsigned char lds_ep[];
    const float* tab = (const float*)(lds_ep + RS_TAB_OFF) + ui * 256;
    unsigned char* ws_ = fresh_args()->ws; float* PS = (float*)(ws_ + WS_PS); bf16_t* XB = (bf16_t*)(ws_ + WS_XN);
    if (mode == 0) {
      bf16_t* O = (bf16_t*)P;
      const int row0 = u.pm * 256 + wr * 64 + fr, col0 = u.pn * 128 + wc * 32 + 8 * fq;
#pragma unroll
      for (int ai = 0; ai < 2; ++ai)
#pragma unroll
        for (int m = 0; m < 4; ++m) {
          const int row = row0 + ai * 128 + m * 16;
          const float rs = tab[wr * 64 + fr + ai * 128 + m * 16];
          bf16_t* rowp = O + (size_t)row * ldc + col0;
          unsigned wv[4];
#pragma unroll
          for (int n = 0; n < 2; ++n)
#pragma unroll
            for (int jp = 0; jp < 2; ++jp) {
              const f32v2_t g = (f32v2_t){acc[ai][0][m][n][2 * jp], acc[ai][0][m][n][2 * jp + 1]} * rs;
              const f32v2_t up = (f32v2_t){acc[ai][1][m][n][2 * jp], acc[ai][1][m][n][2 * jp + 1]} * rs;
              const f32v2_t t = g * (-1.44269504089f);
              f32v2_t e; e.x = __builtin_amdgcn_exp2f(t.x); e.y = __builtin_amdgcn_exp2f(t.y);
              const f32v2_t d = e + 1.0f;
              f32v2_t q; q.x = __builtin_amdgcn_rcpf(d.x); q.y = __builtin_amdgcn_rcpf(d.y);
              const f32v2_t o = (g * up) * q;
              wv[n * 2 + jp] = pk2(o.x, o.y);
            }
          u32x4 w; w.x = wv[0]; w.y = wv[1]; w.z = wv[2]; w.w = wv[3];
          *(u32x4*)rowp = w;
        }
    } else if (mode == 1) {
      float* X = (float*)P;
      const int row0 = u.pm * 256 + wr * 64 + fr, col0 = u.pn * 256 + wc * 32 + 4 * fq;
#pragma unroll
      for (int ai = 0; ai < 2; ++ai)
#pragma unroll
        for (int m = 0; m < 4; ++m) {
          const int row = row0 + ai * 128 + m * 16;
          float* rowp = X + (size_t)row * ldc + col0; bf16_t* rowb = XB + (size_t)row * ldc + col0;
          float ss = 0.f;
#pragma unroll
          for (int bj = 0; bj < 2; ++bj)
#pragma unroll
            for (int n = 0; n < 2; ++n) {
              const f32x4 v = acc[ai][bj][m][n] * scale;
              *(f32x4*)(rowp + bj * 128 + n * 16) = v;
              u32x2 w; w.x = pk2(v[0], v[1]); w.y = pk2(v[2], v[3]); *(u32x2*)(rowb + bj * 128 + n * 16) = w;
              ss += (v[0] * v[0] + v[1] * v[1]) + (v[2] * v[2] + v[3] * v[3]);
            }
          ss += __shfl_xor(ss, 16); ss += __shfl_xor(ss, 32);
          if (fq == 0) PS[(size_t)row * 16 + u.pn * 4 + wc] = ss;
        }
    } else if (mode == 2) {
      bf16_t* O = (bf16_t*)P;
      const int row0 = u.pm * 256 + wr * 64 + fr, col0 = u.pn * 256 + wc * 32 + 8 * fq;
#pragma unroll
      for (int ai = 0; ai < 2; ++ai)
#pragma unroll
        for (int m = 0; m < 4; ++m) {
          const int row = row0 + ai * 128 + m * 16;
          const float rs = tab[wr * 64 + fr + ai * 128 + m * 16];
          bf16_t* rowp = O + (size_t)row * ldc + col0;
#pragma unroll
          for (int bj = 0; bj < 2; ++bj) {
            const f32x4 v0 = acc[ai][bj][m][0] * rs, v1 = acc[ai][bj][m][1] * rs;
            u32x4 w; w.x = pk2(v0[0], v0[1]); w.y = pk2(v0[2], v0[3]); w.z = pk2(v1[0], v1[1]); w.w = pk2(v1[2], v1[3]);
            *(u32x4*)(rowp + bj * 128) = w;
          }
        }
    } else {
      bf16_t* O = (bf16_t*)P;
      const int row0 = u.pm * 256 + wr * 64 + fr, col0 = u.pn * 256 + wc * 32 + 8 * fq;
#pragma unroll
      for (int bj = 0; bj < 2; ++bj) {
        float rc[8];
#pragma unroll
        for (int e = 0; e < 8; ++e) rc[e] = tab[wc * 32 + 8 * fq + bj * 128 + e];
#pragma unroll
        for (int ai = 0; ai < 2; ++ai)
#pragma unroll
          for (int m = 0; m < 4; ++m) {
            bf16_t* rowp = O + (size_t)(row0 + ai * 128 + m * 16) * ldc + col0 + bj * 128;
            const f32x4 v0 = acc[ai][bj][m][0], v1 = acc[ai][bj][m][1];
            u32x4 w; w.x = pk2(v0[0] * rc[0], v0[1] * rc[1]); w.y = pk2(v0[2] * rc[2], v0[3] * rc[3]); w.z = pk2(v1[0] * rc[4], v1[1] * rc[5]); w.w = pk2(v1[2] * rc[6], v1[3] * rc[7]);
            *(u32x4*)rowp = w;
          }
      }
    }
  }
};

__device__ __forceinline__ void transpose_job(float* sT, const float* src, int ld, int K, int ncols, bf16_t* dst, int rs, int roff, int& rot, const float* gain) {
  const int tid = tid_fresh(), G = gridDim.x;
  const int ntn = ncols >> 6, ntiles = (K >> 6) * ntn;
  int first = (int)blockIdx.x - rot; if (first < 0) first += G;
  for (int t = first; t < ntiles; t += G) {
    const int kt = t / ntn, nt = t - kt * ntn; const int k0 = kt * 64, n0 = nt * 64;
    { const int r = tid >> 4, c4 = (tid & 15) * 4;
#pragma unroll
      for (int i = 0; i < 2; ++i) { const float4 v = *(const float4*)(src + (size_t)(k0 + r + 32 * i) * ld + n0 + c4); float* p = sT + (r + 32 * i) * 65 + c4; p[0] = v.x; p[1] = v.y; p[2] = v.z; p[3] = v.w; } }
    __syncthreads();
    { const int n = tid >> 3, ks = (tid & 7) * 8; const float* p = sT + ks * 65 + n;
      float4 ga = make_float4(1.f, 1.f, 1.f, 1.f), gb = ga;
      if (gain) { ga = *(const float4*)(gain + k0 + ks); gb = *(const float4*)(gain + k0 + ks + 4); }
      u32x4 w; w.x = pk2(p[0] * ga.x, p[65] * ga.y); w.y = pk2(p[130] * ga.z, p[195] * ga.w); w.z = pk2(p[260] * gb.x, p[325] * gb.y); w.w = pk2(p[390] * gb.z, p[455] * gb.w);
      const int na = n0 + n; const int row = roff + (na >> 7) * rs + (na & 127);
      *(u32x4*)(dst + (size_t)row * K + k0 + ks) = w; }
    __syncthreads();
  }
  rot = (rot + ntiles) % G;
}

struct ConvJob { const float* src; int ld, K, ntn; bf16_t* dst; int rs, roff; const float* gain; int kt, nt; };
__device__ __forceinline__ ConvJob conv_decode(int t, bool even, int l, int j, ArgsP a, unsigned char* ws) {
  ConvJob J; int base = 0, n;
  const float* gu1 = a->in[2] + (size_t)l * 1024 * 5632; const float* gu2 = a->in[17] + (size_t)l * 1024 * 5632;
#define CJ(cnt, S_, LD_, K_, NC_, D_, RS_, RO_, G_) n = (cnt); if (t < base + n) { J.src = (S_); J.ld = (LD_); J.K = (K_); J.ntn = (NC_) >> 6; J.dst = (D_); J.rs = (RS_); J.roff = (RO_); J.gain = (G_); const int tt = t - base; J.kt = tt / J.ntn; J.nt = tt - J.kt * J.ntn; return J; } base += n;
  CJ(704, gu1, 5632, 1024, 2816, (bf16_t*)(ws + WS_GU1), 256, 0, a->in[1] + l * 1024)
  CJ(704, gu1 + 2816, 5632, 1024, 2816, (bf16_t*)(ws + WS_GU1), 256, 128, a->in[1] + l * 1024)
  CJ(704, a->in[3] + (size_t)l * 2816 * 1024, 1024, 2816, 1024, (bf16_t*)(ws + WS_DN1), 128, 0, nullptr)
  CJ(704, gu2, 5632, 1024, 2816, (bf16_t*)(ws + WS_GU2), 256, 0, a->in[16] + l * 1024)
  CJ(704, gu2 + 2816, 5632, 1024, 2816, (bf16_t*)(ws + WS_GU2), 256, 128, a->in[16] + l * 1024)
  CJ(704, a->in[18] + (size_t)l * 2816 * 1024, 1024, 2816, 1024, (bf16_t*)(ws + WS_DN2), 128, 0, nullptr)
  const float* gm = a->in[4] + l * 1024;
  if (even) {
    const float* wi = a->in[5] + (size_t)j * 1024 * 4108;
    CJ(512, wi, 4108, 1024, 2048, (bf16_t*)(ws + WS_WIN), 128, 0, gm)
    CJ(256, wi + 2056, 4108, 1024, 1024, (bf16_t*)(ws + WS_WIN), 128, 2048, gm)
    CJ(128, wi + 3592, 4108, 1024, 512, (bf16_t*)(ws + WS_WIN), 128, 3072, gm)
    CJ(128, wi + 3080, 4108, 1024, 512, (bf16_t*)(ws + WS_WIN), 128, 3584, gm)
    CJ(256, a->in[13] + (size_t)j * 1024 * 1024, 1024, 1024, 1024, (bf16_t*)(ws + WS_WOUT), 128, 0, nullptr)
  } else {
    CJ(768, a->in[14] + (size_t)j * 1024 * 3072, 3072, 1024, 3072, (bf16_t*)(ws + WS_WIN), 128, 0, gm)
    CJ(256, a->in[15] + (size_t)j * 1024 * 1024, 1024, 1024, 1024, (bf16_t*)(ws + WS_WOUT), 128, 0, nullptr)
  }
#undef CJ
  J.src = nullptr; J.ld = 0; J.K = 0; J.ntn = 1; J.dst = nullptr; J.rs = 0; J.roff = 0; J.gain = nullptr; J.kt = 0; J.nt = 0;
  return J;
}
__device__ __forceinline__ void convert_layer(float* sT, bool even, int l, int j, ArgsP a, unsigned char* ws) {
  const int tid = tid_fresh(), G = gridDim.x;
  const int total = 6 * 704 + (even ? 1280 : 1024);
  const int r = tid >> 4, c4 = (tid & 15) * 4;
  int t = blockIdx.x; asm volatile("" : "+s"(t));
  if (t >= total) return;
  float4 v0, v1;
  { const ConvJob J = conv_decode(t, even, l, j, a, ws);
    v0 = *(const float4*)(J.src + (size_t)(J.kt * 64 + r) * J.ld + J.nt * 64 + c4); v1 = *(const float4*)(J.src + (size_t)(J.kt * 64 + r + 32) * J.ld + J.nt * 64 + c4); }
  for (;;) {
    const int tn = t + G; const bool more = tn < total;
    float4 n0 = v0, n1 = v1;
    if (more) { const ConvJob Jn = conv_decode(tn, even, l, j, a, ws);
      n0 = *(const float4*)(Jn.src + (size_t)(Jn.kt * 64 + r) * Jn.ld + Jn.nt * 64 + c4); n1 = *(const float4*)(Jn.src + (size_t)(Jn.kt * 64 + r + 32) * Jn.ld + Jn.nt * 64 + c4); }
    { float* p = sT + r * 65 + c4; p[0] = v0.x; p[1] = v0.y; p[2] = v0.z; p[3] = v0.w; float* q = sT + (r + 32) * 65 + c4; q[0] = v1.x; q[1] = v1.y; q[2] = v1.z; q[3] = v1.w; }
    __syncthreads();
    { const ConvJob J = conv_decode(t, even, l, j, a, ws);
      const int k0 = J.kt * 64, n = tid >> 3, ks = (tid & 7) * 8; const float* p = sT + ks * 65 + n;
      float4 ga = make_float4(1.f, 1.f, 1.f, 1.f), gb = ga;
      if (J.gain) { ga = *(const float4*)(J.gain + k0 + ks); gb = *(const float4*)(J.gain + k0 + ks + 4); }
      u32x4 w; w.x = pk2(p[0] * ga.x, p[65] * ga.y); w.y = pk2(p[130] * ga.z, p[195] * ga.w); w.z = pk2(p[260] * gb.x, p[325] * gb.y); w.w = pk2(p[390] * gb.z, p[455] * gb.w);
      const int na = J.nt * 64 + n; const int row = J.roff + (na >> 7) * J.rs + (na & 127);
      *(u32x4*)(J.dst + (size_t)row * J.K + k0 + ks) = w; }
    __syncthreads();
    if (!more) break;
    t = tn; v0 = n0; v1 = n1;
  }
}

template <bool SMALL>
__device__ __forceinline__ void norm_phase(unsigned char* lds, const float* xsrc, float* xcopy, const float* gain, bf16_t* XN,
                                           const float* w_in, const float* a_log, const float* dt_bias, const float* f_bias, float* SM) {
  const int tid = tid_fresh(), lane = tid & 63, wave = tid >> 6;
  float* ws_s = (float*)lds;
  if (SMALL) {
    for (int e = tid; e < 12288; e += 512) { const int k = e / 12, c = e - k * 12; const int col = c < 8 ? 2048 + c : 4096 + c; ws_s[c * 1024 + k] = w_in[(size_t)k * 4108 + col]; }
    __syncthreads();
  }
  float4 gv[4];
#pragma unroll
  for (int j = 0; j < 4; ++j) gv[j] = *(const float4*)(gain + lane * 4 + 256 * j);
  float4 xnx[4];
  { const int row0 = blockIdx.x * 8 + wave;
#pragma unroll
    for (int j = 0; j < 4; ++j) xnx[j] = *(const float4*)(xsrc + (size_t)(row0 < T ? row0 : 0) * 1024 + lane * 4 + 256 * j); }
  for (int row = blockIdx.x * 8 + wave; row < T; row += gridDim.x * 8) {
    float4 xv[4]; float ss = 0.f;
#pragma unroll
    for (int j = 0; j < 4; ++j) xv[j] = xnx[j];
    { const int rn = row + gridDim.x * 8;
      if (rn < T) {
#pragma unroll
        for (int j = 0; j < 4; ++j) xnx[j] = *(const float4*)(xsrc + (size_t)rn * 1024 + lane * 4 + 256 * j);
      } }
#pragma unroll
    for (int j = 0; j < 4; ++j) ss += xv[j].x * xv[j].x + xv[j].y * xv[j].y + xv[j].z * xv[j].z + xv[j].w * xv[j].w;
    if (xcopy) {
#pragma unroll
      for (int j = 0; j < 4; ++j) *(float4*)(xcopy + (size_t)row * 1024 + lane * 4 + 256 * j) = xv[j];
    }
    ss = wave_sum(ss);
    const float rstd = rsqrtf(ss * (1.f / 1024.f) + EPS);
#pragma unroll
    for (int j = 0; j < 4; ++j) {
      xv[j].x = xv[j].x * rstd * gv[j].x; xv[j].y = xv[j].y * rstd * gv[j].y; xv[j].z = xv[j].z * rstd * gv[j].z; xv[j].w = xv[j].w * rstd * gv[j].w;
      if (XN) { u32x2 w; w.x = pk2(xv[j].x, xv[j].y); w.y = pk2(xv[j].z, xv[j].w); *(u32x2*)(XN + (size_t)row * 1024 + lane * 4 + 256 * j) = w; }
    }
    if (SMALL) {
      float* red = (float*)(lds + 49152) + wave * (12 * 68);
#pragma unroll
      for (int c = 0; c < 12; ++c) {
        float d = 0.f;
#pragma unroll
        for (int j = 0; j < 4; ++j) { const float4 wv = *(const float4*)(ws_s + c * 1024 + lane * 4 + 256 * j); d += xv[j].x * wv.x + xv[j].y * wv.y + xv[j].z * wv.z + xv[j].w * wv.w; }
        red[c * 68 + lane] = d;
      }
      float mine = 0.f;
      if (lane < 12) {
        float s0 = 0.f, s1 = 0.f, s2 = 0.f, s3 = 0.f;
#pragma unroll
        for (int i4 = 0; i4 < 16; ++i4) { const float4 v = *(const float4*)(red + lane * 68 + 4 * i4); s0 += v.x; s1 += v.y; s2 += v.z; s3 += v.w; }
        mine = (s0 + s1) + (s2 + s3);
      }
      if (lane < 12) {
        const int h = lane & 3; float o;
        if (lane < 4) o = sigmoid_(mine);
        else if (lane < 8) o = -__expf(a_log[h]) * softplus_(mine + dt_bias[h]);
        else o = -softplus_(-(mine + f_bias[h]));
        SM[(size_t)row * 16 + lane] = o;
      }
    }
  }
  if (SMALL) __syncthreads();
}


__device__ __forceinline__ void init_phase(const float* xin, float* X, bf16_t* XB, float* PS) {
  const int tid = tid_fresh(), lane = tid & 63, wave = tid >> 6;
  for (int row = blockIdx.x * 8 + wave; row < T; row += gridDim.x * 8) {
    float ss = 0.f;
#pragma unroll
    for (int j = 0; j < 4; ++j) {
      const float4 v = *(const float4*)(xin + (size_t)row * 1024 + lane * 4 + 256 * j);
      *(float4*)(X + (size_t)row * 1024 + lane * 4 + 256 * j) = v;
      u32x2 w; w.x = pk2(v.x, v.y); w.y = pk2(v.z, v.w); *(u32x2*)(XB + (size_t)row * 1024 + lane * 4 + 256 * j) = w;
      ss += (v.x * v.x + v.y * v.y) + (v.z * v.z + v.w * v.w);
    }
    ss = wave_sum(ss);
    if (lane < 16) PS[(size_t)row * 16 + lane] = (lane == 0) ? ss : 0.f;
  }
}

__device__ __forceinline__ void cumsum_logf(unsigned char* lds, const float* SM, float* CF) {
  if (blockIdx.x < 16) {
    const int tid = tid_fresh(), lane = tid & 63, wave = tid >> 6;
    const int seq = blockIdx.x, b = seq >> 2, h = seq & 3; float* red = (float*)lds;
    float v[8]; float run = 0.f;
#pragma unroll
    for (int e = 0; e < 8; ++e) { run += SM[((size_t)(b * 4096 + tid * 8 + e)) * 16 + 8 + h]; v[e] = run; }
    float sc = run;
#pragma unroll
    for (int o = 1; o < 64; o <<= 1) { const float t = __shfl_up(sc, o); if (lane >= o) sc += t; }
    if (lane == 63) red[wave] = sc;
    __syncthreads();
    float base = sc - run;
    for (int w2 = 0; w2 < wave; ++w2) base += red[w2];
#pragma unroll
    for (int e = 0; e < 8; ++e) CF[seq * 4096 + tid * 8 + e] = v[e] + base;
    __syncthreads();
  }
}

#define MFMA16(a, b, c) __builtin_amdgcn_mfma_f32_16x16x32_bf16((a), (b), (c), 0, 0, 0)

__device__ __forceinline__ void dn_prep_unit(unsigned char* lds, int u, const bf16_t* BIG, const float* SM, const float* convw, unsigned char* DNX, float* GL) {
  const int tid = tid_fresh(), lane = tid & 63, wave = tid >> 6;
  bf16_t* q_s = (bf16_t*)lds; bf16_t* k_s = (bf16_t*)(lds + 17408); float* A_s = (float*)(lds + 34816);
  float* gc_s = (float*)(lds + 52224); float* beta_s = (float*)(lds + 52480); float* rhs = (float*)(lds + 52736); float* cw_s = (float*)(lds + 118272);
  const int bh = u >> 6, n = u & 63, b = bh >> 2, h = bh & 3; const int t0 = b * SEQ + n * 64;
  unsigned char* ux = DNX + (size_t)u * DNX_UNIT;
  bf16_t* UT = (bf16_t*)ux; bf16_t* Wd = (bf16_t*)(ux + 16384); bf16_t* QD = (bf16_t*)(ux + 32768); bf16_t* KDT = (bf16_t*)(ux + 49152); bf16_t* AT = (bf16_t*)(ux + 65536);
  const int s = tid >> 3, c0 = (tid & 7) * 16;
  u32x4 xr[3][4][2];
#pragma unroll
  for (int sel = 0; sel < 3; ++sel)
#pragma unroll
    for (int i = 0; i < 4; ++i) {
      const int sr = n * 64 + s - 3 + i; const int srl = sr < 0 ? 0 : sr;
      const bf16_t* xp = BIG + (size_t)(b * SEQ + srl) * 3584 + sel * 512 + h * 128 + c0;
      xr[sel][i][0] = *(const u32x4*)xp; xr[sel][i][1] = *(const u32x4*)(xp + 8);
    }
  if (tid < 64) {
    float g = SM[(size_t)(t0 + tid) * 16 + 4 + h];
#pragma unroll
    for (int o = 1; o < 64; o <<= 1) { const float t = __shfl_up(g, o); if (lane >= o) g += t; }
    gc_s[tid] = g; beta_s[tid] = SM[(size_t)(t0 + tid) * 16 + h];
    if (tid == 63) GL[u] = __expf(g);
  }
  for (int e = tid; e < 1536; e += 512) { const int i = e / 384, r = e - i * 384, sel = r >> 7, c = r & 127; cw_s[e] = convw[i * 1536 + sel * 512 + h * 128 + c]; }
  __syncthreads();
#ifndef NREP_CV
#define NREP_CV 1
#endif
  for (int rep_cv = 0; rep_cv < NREP_CV; ++rep_cv)
  {
    const float bs = beta_s[s], eg = __expf(gc_s[s]);
#pragma unroll
    for (int sel = 0; sel < 3; ++sel) {
      float a[16];
#pragma unroll
      for (int e = 0; e < 16; ++e) a[e] = 0.f;
#pragma unroll
      for (int i = 0; i < 4; ++i) {
        const int sr = n * 64 + s - 3 + i; const float mk = sr < 0 ? 0.f : 1.f;
        const u32x4 x0 = xr[sel][i][0], x1 = xr[sel][i][1];
        const float* wp = cw_s + i * 384 + sel * 128 + c0;
        float4 w0 = *(const float4*)wp, w1 = *(const float4*)(wp + 4), w2 = *(const float4*)(wp + 8), w3 = *(const float4*)(wp + 12);
        w0.x *= mk; w0.y *= mk; w0.z *= mk; w0.w *= mk; w1.x *= mk; w1.y *= mk; w1.z *= mk; w1.w *= mk;
        w2.x *= mk; w2.y *= mk; w2.z *= mk; w2.w *= mk; w3.x *= mk; w3.y *= mk; w3.z *= mk; w3.w *= mk;
        a[0] += bflo(x0.x) * w0.x; a[1] += bfhi(x0.x) * w0.y; a[2] += bflo(x0.y) * w0.z; a[3] += bfhi(x0.y) * w0.w;
        a[4] += bflo(x0.z) * w1.x; a[5] += bfhi(x0.z) * w1.y; a[6] += bflo(x0.w) * w1.z; a[7] += bfhi(x0.w) * w1.w;
        a[8] += bflo(x1.x) * w2.x; a[9] += bfhi(x1.x) * w2.y; a[10] += bflo(x1.y) * w2.z; a[11] += bfhi(x1.y) * w2.w;
        a[12] += bflo(x1.z) * w3.x; a[13] += bfhi(x1.z) * w3.y; a[14] += bflo(x1.w) * w3.z; a[15] += bfhi(x1.w) * w3.w;
      }
      float ss = 0.f;
#pragma unroll
      for (int e = 0; e < 16; ++e) { a[e] = silu_(a[e]); ss += a[e] * a[e]; }
      if (sel < 2) {
        ss += __shfl_xor(ss, 1); ss += __shfl_xor(ss, 2); ss += __shfl_xor(ss, 4);
        const float r = rsqrtf(ss + EPS) * (sel == 0 ? QSCALE : 1.f);
#pragma unroll
        for (int e = 0; e < 16; ++e) a[e] *= r;
        bf16_t* dsts = (sel == 0 ? q_s : k_s) + s * 136 + c0;
        u32x4 p0, p1;
        p0.x = pk2(a[0], a[1]); p0.y = pk2(a[2], a[3]); p0.z = pk2(a[4], a[5]); p0.w = pk2(a[6], a[7]);
        p1.x = pk2(a[8], a[9]); p1.y = pk2(a[10], a[11]); p1.z = pk2(a[12], a[13]); p1.w = pk2(a[14], a[15]);
        *(u32x4*)dsts = p0; *(u32x4*)(dsts + 8) = p1;
        if (sel == 0) {
          u32x4 d0, d1;
          d0.x = pk2(a[0] * eg, a[1] * eg); d0.y = pk2(a[2] * eg, a[3] * eg); d0.z = pk2(a[4] * eg, a[5] * eg); d0.w = pk2(a[6] * eg, a[7] * eg);
          d1.x = pk2(a[8] * eg, a[9] * eg); d1.y = pk2(a[10] * eg, a[11] * eg); d1.z = pk2(a[12] * eg, a[13] * eg); d1.w = pk2(a[14] * eg, a[15] * eg);
          *(u32x4*)(QD + s * 128 + c0) = d0; *(u32x4*)(QD + s * 128 + c0 + 8) = d1;
        } else {
          const float f = bs * eg; float* rp = rhs + s * 256 + 128 + c0;
#pragma unroll
          for (int e4 = 0; e4 < 4; ++e4) *(float4*)(rp + 4 * e4) = make_float4(a[4 * e4] * f, a[4 * e4 + 1] * f, a[4 * e4 + 2] * f, a[4 * e4 + 3] * f);
        }
      } else {
        float* rp = rhs + s * 256 + c0;
#pragma unroll
        for (int e4 = 0; e4 < 4; ++e4) *(float4*)(rp + 4 * e4) = make_float4(a[4 * e4] * bs, a[4 * e4 + 1] * bs, a[4 * e4 + 2] * bs, a[4 * e4 + 3] * bs);
      }
    }
  }
  __syncthreads();
#ifndef NREP_MM
#define NREP_MM 1
#endif
  for (int rep_mm = 0; rep_mm < NREP_MM; ++rep_mm)
  {
    const int it = wave & 3, sel = wave >> 2, fr = lane & 15, fq = lane >> 4;
    const bf16_t* As = (sel ? q_s : k_s) + (it * 16 + fr) * 136 + fq * 8;
    bf16x8 af[4];
#pragma unroll
    for (int kk = 0; kk < 4; ++kk) af[kk] = *(const bf16x8*)(As + 32 * kk);
#pragma unroll
    for (int jt = 0; jt < 4; ++jt) {
      f32x4 acc = {0.f, 0.f, 0.f, 0.f};
      if (jt <= it) {
        const bf16_t* Bs = k_s + (jt * 16 + fr) * 136 + fq * 8;
#pragma unroll
        for (int kk = 0; kk < 4; ++kk) acc = MFMA16(af[kk], *(const bf16x8*)(Bs + 32 * kk), acc);
      }
      const int jj = jt * 16 + fr; const float gj = gc_s[jj];
#pragma unroll
      for (int j = 0; j < 4; ++j) {
        const int i = it * 16 + fq * 4 + j;
        const float dec = __expf(fminf(gc_s[i] - gj, 0.f));
        if (sel == 0) A_s[i * 68 + jj] = (i > jj) ? beta_s[i] * acc[j] * dec : 0.f;
        else { const float v = (i >= jj) ? acc[j] * dec : 0.f; AT[i * 64 + jj] = (bf16_t)(pk2(v, 0.f) & 0xffffu); }
      }
    }
  }
  {
    const int d = tid >> 2, sg = (tid & 3) * 16; const float gl = gc_s[63];
    float v[16];
#pragma unroll
    for (int e = 0; e < 16; ++e) v[e] = bf2f(k_s[(sg + e) * 136 + d]) * __expf(gl - gc_s[sg + e]);
    u32x4 p0, p1;
    p0.x = pk2(v[0], v[1]); p0.y = pk2(v[2], v[3]); p0.z = pk2(v[4], v[5]); p0.w = pk2(v[6], v[7]);
    p1.x = pk2(v[8], v[9]); p1.y = pk2(v[10], v[11]); p1.z = pk2(v[12], v[13]); p1.w = pk2(v[14], v[15]);
    *(u32x4*)(KDT + d * 64 + sg) = p0; *(u32x4*)(KDT + d * 64 + sg + 8) = p1;
  }
  __syncthreads();
#ifndef NREP_FS
#define NREP_FS 1
#endif
  float* Ti_s = (float*)(lds + 124416);
  if (wave < 4 && lane < 16) {
    const int I = wave; const float* Ab = A_s + (I * 16) * 68 + I * 16;
    float t[16];
#pragma unroll
    for (int r = 0; r < 16; ++r) {
      float v = (r == lane) ? 1.f : 0.f;
#pragma unroll
      for (int j = 0; j < r; ++j) v -= Ab[r * 68 + j] * t[j];
      t[r] = v;
    }
#pragma unroll
    for (int r = 0; r < 16; ++r) Ti_s[(I * 16 + r) * 20 + lane] = t[r];
  }
  __syncthreads();
  for (int rep_fs = 0; rep_fs < NREP_FS; ++rep_fs)
  {
    const int fr = lane & 15, fq = lane >> 4;
#pragma unroll
    for (int I = 0; I < 4; ++I) {
      f32x4 ac[2];
      ac[0] = (f32x4){0.f, 0.f, 0.f, 0.f}; ac[1] = (f32x4){0.f, 0.f, 0.f, 0.f};
#pragma unroll
      for (int J = 0; J < I; ++J)
#pragma unroll
        for (int kk = 0; kk < 4; ++kk) {
          const float a = A_s[(I * 16 + fr) * 68 + J * 16 + 4 * kk + fq];
#pragma unroll
          for (int c2 = 0; c2 < 2; ++c2) ac[c2] = __builtin_amdgcn_mfma_f32_16x16x4f32(a, rhs[(J * 16 + 4 * kk + fq) * 256 + wave * 32 + c2 * 16 + fr], ac[c2], 0, 0, 0);
        }
#pragma unroll
      for (int c2 = 0; c2 < 2; ++c2)
#pragma unroll
        for (int j = 0; j < 4; ++j) { float* p = rhs + (I * 16 + fq * 4 + j) * 256 + wave * 32 + c2 * 16 + fr; *p = *p - ac[c2][j]; }
      f32x4 xc[2];
      xc[0] = (f32x4){0.f, 0.f, 0.f, 0.f}; xc[1] = (f32x4){0.f, 0.f, 0.f, 0.f};
#pragma unroll
      for (int kk = 0; kk < 4; ++kk) {
        const float a = Ti_s[(I * 16 + fr) * 20 + 4 * kk + fq];
#pragma unroll
        for (int c2 = 0; c2 < 2; ++c2) xc[c2] = __builtin_amdgcn_mfma_f32_16x16x4f32(a, rhs[(I * 16 + 4 * kk + fq) * 256 + wave * 32 + c2 * 16 + fr], xc[c2], 0, 0, 0);
      }
#pragma unroll
      for (int c2 = 0; c2 < 2; ++c2)
#pragma unroll
        for (int j = 0; j < 4; ++j) rhs[(I * 16 + fq * 4 + j) * 256 + wave * 32 + c2 * 16 + fr] = xc[c2][j];
    }
  }
  __syncthreads();
  {
    const int wi = tid >> 3, wseg = (tid & 7) * 16;
    const float* wp = rhs + wi * 256 + 128 + wseg;
    const float4 w0 = *(const float4*)wp, w1 = *(const float4*)(wp + 4), w2 = *(const float4*)(wp + 8), w3 = *(const float4*)(wp + 12);
    u32x4 p0, p1;
    p0.x = pk2(w0.x, w0.y); p0.y = pk2(w0.z, w0.w); p0.z = pk2(w1.x, w1.y); p0.w = pk2(w1.z, w1.w);
    p1.x = pk2(w2.x, w2.y); p1.y = pk2(w2.z, w2.w); p1.z = pk2(w3.x, w3.y); p1.w = pk2(w3.z, w3.w);
    *(u32x4*)(Wd + wi * 128 + wseg) = p0; *(u32x4*)(Wd + wi * 128 + wseg + 8) = p1;
    const int un = tid >> 2, uc = (tid & 3) * 16;
    float uv[16];
#pragma unroll
    for (int e = 0; e < 16; ++e) uv[e] = rhs[(uc + e) * 256 + un];
    u32x4 q0, q1;
    q0.x = pk2(uv[0], uv[1]); q0.y = pk2(uv[2], uv[3]); q0.z = pk2(uv[4], uv[5]); q0.w = pk2(uv[6], uv[7]);
    q1.x = pk2(uv[8], uv[9]); q1.y = pk2(uv[10], uv[11]); q1.z = pk2(uv[12], uv[13]); q1.w = pk2(uv[14], uv[15]);
    *(u32x4*)(UT + un * 64 + uc) = q0; *(u32x4*)(UT + un * 64 + uc + 8) = q1;
  }
  __syncthreads();
}

__device__ __forceinline__ void dn_scan(unsigned char* lds, int sid, const unsigned char* DNX, const float* GL, float* OF, float* PSD) {
  const int tid = tid_fresh(), lane = tid & 63, wave = tid >> 6, fr = lane & 15, fq = lane >> 4;
  bf16_t* w_s = (bf16_t*)lds; bf16_t* qd_s = (bf16_t*)(lds + 17408); bf16_t* kdT_s = (bf16_t*)(lds + 34816); bf16_t* at_s = (bf16_t*)(lds + 53248);
  bf16_t* ST_s = (bf16_t*)(lds + 62464); bf16_t* vT_s = (bf16_t*)(lds + 71168);
  const int bh = sid >> 2, sl = sid & 3, b = bh >> 2, h = bh & 3;
  for (int e = tid; e < 32 * 136 / 2; e += 512) ((unsigned*)ST_s)[e] = 0u;
  f32x4 Sacc[2];
  Sacc[0] = (f32x4){0.f, 0.f, 0.f, 0.f}; Sacc[1] = (f32x4){0.f, 0.f, 0.f, 0.f};
  const int r64 = tid >> 4, c16 = (tid & 15) * 8;
  const int r128 = tid >> 3, c8 = (tid & 7) * 8;
  u32x4 rw[2], rq[2], rk[2], ra; u32x2 ru[2]; float rgl;
  ru[0] = (u32x2){0u, 0u}; ru[1] = (u32x2){0u, 0u};
#define DN_LOAD(nc) do { const unsigned char* ux = DNX + (size_t)((bh << 6) + (nc)) * DNX_UNIT; \
    const bf16_t* UTg = (const bf16_t*)ux; const bf16_t* Wg = (const bf16_t*)(ux + 16384); const bf16_t* QDg = (const bf16_t*)(ux + 32768); \
    const bf16_t* KDTg = (const bf16_t*)(ux + 49152); const bf16_t* ATg = (const bf16_t*)(ux + 65536); \
    _Pragma("unroll") for (int i = 0; i < 2; ++i) { rw[i] = *(const u32x4*)(Wg + (r64 + 32 * i) * 128 + c16); rq[i] = *(const u32x4*)(QDg + (r64 + 32 * i) * 128 + c16); \
      rk[i] = *(const u32x4*)(KDTg + (r128 + 64 * i) * 64 + c8); } \
    ra = *(const u32x4*)(ATg + r128 * 64 + c8); \
    if (wave < 4) { _Pragma("unroll") for (int c2 = 0; c2 < 2; ++c2) ru[c2] = *(const u32x2*)(UTg + (sl * 32 + c2 * 16 + fr) * 64 + wave * 16 + fq * 4); } \
    rgl = GL[(bh << 6) + (nc)]; } while (0)
  DN_LOAD(0);
  for (int nc = 0; nc < 64; ++nc) {
#pragma unroll
    for (int i = 0; i < 2; ++i) { *(u32x4*)(w_s + (r64 + 32 * i) * 136 + c16) = rw[i]; *(u32x4*)(qd_s + (r64 + 32 * i) * 136 + c16) = rq[i]; *(u32x4*)(kdT_s + (r128 + 64 * i) * 72 + c8) = rk[i]; }
    *(u32x4*)(at_s + r128 * 72 + c8) = ra;
    const u32x2 uc0 = ru[0], uc1 = ru[1];
    const float gl = rgl;
    __syncthreads();
    if (nc + 1 < 64) DN_LOAD(nc + 1);
    f32x4 P[2];
    {
      const bf16_t* Ar = (wave < 4 ? w_s : qd_s) + ((wave & 3) * 16 + fr) * 136 + fq * 8;
      bf16x8 af[4];
#pragma unroll
      for (int kk = 0; kk < 4; ++kk) af[kk] = *(const bf16x8*)(Ar + 32 * kk);
#pragma unroll
      for (int c2 = 0; c2 < 2; ++c2) {
        P[c2] = (f32x4){0.f, 0.f, 0.f, 0.f};
#pragma unroll
        for (int kk = 0; kk < 4; ++kk) P[c2] = MFMA16(af[kk], *(const bf16x8*)(ST_s + (c2 * 16 + fr) * 136 + fq * 8 + 32 * kk), P[c2]);
      }
    }
    if (wave < 4) {
      { const float v0 = bflo(uc0.x) - P[0][0], v1 = bfhi(uc0.x) - P[0][1], v2 = bflo(uc0.y) - P[0][2], v3 = bfhi(uc0.y) - P[0][3];
        u32x2 p; p.x = pk2(v0, v1); p.y = pk2(v2, v3); *(u32x2*)(vT_s + (fr) * 72 + wave * 16 + fq * 4) = p; }
      { const float v0 = bflo(uc1.x) - P[1][0], v1 = bfhi(uc1.x) - P[1][1], v2 = bflo(uc1.y) - P[1][2], v3 = bfhi(uc1.y) - P[1][3];
        u32x2 p; p.x = pk2(v0, v1); p.y = pk2(v2, v3); *(u32x2*)(vT_s + (16 + fr) * 72 + wave * 16 + fq * 4) = p; }
    }
    __syncthreads();
    if (wave >= 4) {
      const int ct = wave - 4;
      bf16x8 aa[2];
#pragma unroll
      for (int g = 0; g < 2; ++g) aa[g] = *(const bf16x8*)(at_s + (ct * 16 + fr) * 72 + fq * 8 + 32 * g);
#pragma unroll
      for (int c2 = 0; c2 < 2; ++c2)
#pragma unroll
        for (int g = 0; g < 2; ++g) P[c2] = MFMA16(aa[g], *(const bf16x8*)(vT_s + (c2 * 16 + fr) * 72 + fq * 8 + 32 * g), P[c2]);
      const int t0 = b * SEQ + nc * 64 + ct * 16 + fq * 4;
#pragma unroll
      for (int j = 0; j < 4; ++j) {
        float* op = OF + (size_t)(t0 + j) * 512 + h * 128 + sl * 32 + fr;
        op[0] = P[0][j]; op[16] = P[1][j];
        float ss = P[0][j] * P[0][j] + P[1][j] * P[1][j];
        ss += __shfl_xor(ss, 1); ss += __shfl_xor(ss, 2); ss += __shfl_xor(ss, 4); ss += __shfl_xor(ss, 8);
        if (fr == 0) PSD[(size_t)(t0 + j) * 16 + h * 4 + sl] = ss;
      }
    }
    {
      bf16x8 ak[2];
#pragma unroll
      for (int g = 0; g < 2; ++g) ak[g] = *(const bf16x8*)(kdT_s + (wave * 16 + fr) * 72 + fq * 8 + 32 * g);
#pragma unroll
      for (int n2 = 0; n2 < 2; ++n2) {
        f32x4 a = Sacc[n2] * gl;
#pragma unroll
        for (int g = 0; g < 2; ++g) a = MFMA16(ak[g], *(const bf16x8*)(vT_s + (n2 * 16 + fr) * 72 + fq * 8 + 32 * g), a);
        Sacc[n2] = a;
        u32x2 p; p.x = pk2(a[0], a[1]); p.y = pk2(a[2], a[3]);
        *(u32x2*)(ST_s + (n2 * 16 + fr) * 136 + wave * 16 + fq * 4) = p;
      }
    }
    __syncthreads();
  }
#undef DN_LOAD
}

__device__ __forceinline__ void dn_fixup(const float* OF, const float* PSD, const bf16_t* BIG, const float* ng, bf16_t* OB) {
  const int tid = tid_fresh();
  for (int it = blockIdx.x * 512 + tid; it < T * 32; it += gridDim.x * 512) {
    const int t = it >> 5, h = (it >> 3) & 3, n0 = (it & 7) * 16;
    const float4 ps = *(const float4*)(PSD + (size_t)t * 16 + h * 4);
    const float rstd = rsqrtf((ps.x + ps.y + ps.z + ps.w) * (1.f / 128.f) + EPS);
    const float* op = OF + (size_t)t * 512 + h * 128 + n0;
    const bf16_t* gp = BIG + (size_t)t * 3584 + 1536 + h * 128 + n0;
    const u32x4 g0 = *(const u32x4*)gp, g1 = *(const u32x4*)(gp + 8);
    float gt[16];
    gt[0] = bflo(g0.x); gt[1] = bfhi(g0.x); gt[2] = bflo(g0.y); gt[3] = bfhi(g0.y); gt[4] = bflo(g0.z); gt[5] = bfhi(g0.z); gt[6] = bflo(g0.w); gt[7] = bfhi(g0.w);
    gt[8] = bflo(g1.x); gt[9] = bfhi(g1.x); gt[10] = bflo(g1.y); gt[11] = bfhi(g1.y); gt[12] = bflo(g1.z); gt[13] = bfhi(g1.z); gt[14] = bflo(g1.w); gt[15] = bfhi(g1.w);
    float o[16];
#pragma unroll
    for (int e4 = 0; e4 < 4; ++e4) { const float4 v = *(const float4*)(op + 4 * e4); const float4 gn = *(const float4*)(ng + n0 + 4 * e4);
      o[4 * e4] = v.x * rstd * gn.x * silu_(gt[4 * e4]); o[4 * e4 + 1] = v.y * rstd * gn.y * silu_(gt[4 * e4 + 1]);
      o[4 * e4 + 2] = v.z * rstd * gn.z * silu_(gt[4 * e4 + 2]); o[4 * e4 + 3] = v.w * rstd * gn.w * silu_(gt[4 * e4 + 3]); }
    u32x4 p0, p1;
    p0.x = pk2(o[0], o[1]); p0.y = pk2(o[2], o[3]); p0.z = pk2(o[4], o[5]); p0.w = pk2(o[6], o[7]);
    p1.x = pk2(o[8], o[9]); p1.y = pk2(o[10], o[11]); p1.z = pk2(o[12], o[13]); p1.w = pk2(o[14], o[15]);
    bf16_t* ob = OB + (size_t)t * 1024 + h * 128 + n0;
    *(u32x4*)ob = p0; *(u32x4*)(ob + 8) = p1;
  }
}

struct AttnP {
  const bf16_t* Q; const bf16_t* K; int ld;
  const bf16_t* VT;
  const float* qg; const float* kg; const float* CF; const bf16_t* gate;
  bf16_t* O;
  int H;
};
template <bool SBK>
__device__ __forceinline__ void attn_unit(unsigned char* lds, const AttnP& P, int bh, int qb) {
  const int tid = tid_fresh(), lane = tid & 63, wave = tid >> 6, fr = lane & 15, fq = lane >> 4;
  bf16_t* K_s = (bf16_t*)lds; bf16_t* V_s = (bf16_t*)(lds + 69632); float* ck_s = (float*)(lds + 143360); volatile int* dflag = (volatile int*)(lds + 144384);
  const int b = bh / P.H, h = bh - b * P.H; const int tb = b * SEQ;
  const int q = qb * 128 + wave * 16 + fr;
  const int qmin_w = qb * 128 + wave * 16, qmax_w = qmin_w + 15;
  const int ld = P.ld;
  bf16x8 Ue, Uo, U1;
  {
    u32x4 e, o, one;
    const unsigned ONE = 0x3F80u;
    unsigned t[4];
#pragma unroll
    for (int i = 0; i < 4; ++i) t[i] = (fq * 4 + i > fr) ? ONE : 0u;
    e.x = t[0] | (t[1] << 16); e.y = t[2] | (t[3] << 16); e.z = ONE | (ONE << 16); e.w = ONE | (ONE << 16);
    o.x = 0u; o.y = 0u; o.z = t[0] | (t[1] << 16); o.w = t[2] | (t[3] << 16);
    one.x = one.y = one.z = one.w = ONE | (ONE << 16);
    Ue = __builtin_bit_cast(bf16x8, e); Uo = __builtin_bit_cast(bf16x8, o); U1 = __builtin_bit_cast(bf16x8, one);
  }
  const int nt = 2 * qb + 2;
  f32x4 acc_o[8];
#pragma unroll
  for (int dt = 0; dt < 8; ++dt) acc_o[dt] = (f32x4){0.f, 0.f, 0.f, 0.f};
  float m_run = -INFINITY, l_run = 0.f, R = 0.f;
  const int kr = tid >> 4, kc = (tid & 15) * 8;
  const int vr = tid >> 3, vc = (tid & 7) * 8;
  u32x4 rk[2][2], rv[2][2]; float rc = 0.f, rcn = 0.f;
#define AT_LOAD(tp) do {   \
    _Pragma("unroll") for (int sb = 0; sb < 2; ++sb) { const int k0_ = (2 * (tp) + 1 - sb) * 64; \
      _Pragma("unroll") for (int i = 0; i < 2; ++i) { rk[sb][i] = *(const u32x4*)(P.K + (size_t)(tb + k0_ + kr + 32 * i) * ld + h * 128 + kc); \
        rv[sb][i] = *(const u32x4*)(P.VT + (size_t)(h * 128 + vr + 64 * i) * T + tb + k0_ + vc); } } \
    if (!SBK) { if (tid < 128) rc = P.CF[bh * SEQ + (2 * (tp) + 1 - (tid >> 6)) * 64 + (tid & 63)]; rcn = P.CF[bh * SEQ + (2 * (tp) + 1) * 64 + 63]; } } while (0)
#define AT_STORE(buf) do { \
    _Pragma("unroll") for (int sb = 0; sb < 2; ++sb) \
      _Pragma("unroll") for (int i = 0; i < 2; ++i) { \
        *(u32x4*)(K_s + ((buf) * 2 + sb) * 8704 + (kr + 32 * i) * 136 + kc) = rk[sb][i]; \
        *(u32x4*)(V_s + ((buf) * 2 + sb) * 9216 + (vr + 64 * i) * 72 + vc) = rv[sb][i]; } \
    if (!SBK && tid < 128) ck_s[((buf) * 2 + (tid >> 6)) * 64 + (tid & 63)] = rc; } while (0)
  const int np2 = qb + 1;
  AT_LOAD(np2 - 1);
  bf16x8 qf[4];
  float zmax = 0.f;
  {
    const bf16_t* qp = P.Q + (size_t)(tb + q) * ld + h * 128 + fq * 8;
    float v[32]; float ss = 0.f;
#pragma unroll
    for (int kk = 0; kk < 4; ++kk) {
      const u32x4 x = *(const u32x4*)(qp + 32 * kk);
      v[kk * 8 + 0] = bflo(x.x); v[kk * 8 + 1] = bfhi(x.x); v[kk * 8 + 2] = bflo(x.y); v[kk * 8 + 3] = bfhi(x.y);
      v[kk * 8 + 4] = bflo(x.z); v[kk * 8 + 5] = bfhi(x.z); v[kk * 8 + 6] = bflo(x.w); v[kk * 8 + 7] = bfhi(x.w);
    }
    float sc = QSCALE;
    float gqm = 0.f, gkm = 0.f;
    if (!SBK) {
#pragma unroll
      for (int e = 0; e < 32; ++e) ss += v[e] * v[e];
      ss += __shfl_xor(ss, 16); ss += __shfl_xor(ss, 32);
      sc = QSCALE * rsqrtf(ss * (1.f / 128.f) + EPS);
    }
#pragma unroll
    for (int kk = 0; kk < 4; ++kk) {
      float g[8];
#pragma unroll
      for (int e = 0; e < 8; ++e) { g[e] = SBK ? 1.f : P.qg[fq * 8 + 32 * kk + e]; if (!SBK) { gqm = fmaxf(gqm, fabsf(g[e])); gkm = fmaxf(gkm, fabsf(P.kg[fq * 8 + 32 * kk + e])); } }
      u32x4 w;
      w.x = pk2(v[kk * 8 + 0] * sc * g[0], v[kk * 8 + 1] * sc * g[1]); w.y = pk2(v[kk * 8 + 2] * sc * g[2], v[kk * 8 + 3] * sc * g[3]);
      w.z = pk2(v[kk * 8 + 4] * sc * g[4], v[kk * 8 + 5] * sc * g[5]); w.w = pk2(v[kk * 8 + 6] * sc * g[6], v[kk * 8 + 7] * sc * g[7]);
      qf[kk] = __builtin_bit_cast(bf16x8, w);
    }
    if (!SBK) {
      gqm = fmaxf(gqm, __shfl_xor(gqm, 16)); gqm = fmaxf(gqm, __shfl_xor(gqm, 32));
      gkm = fmaxf(gkm, __shfl_xor(gkm, 16)); gkm = fmaxf(gkm, __shfl_xor(gkm, 32));
      zmax = 11.3137085f * gqm * gkm * 1.02f + 0.5f;
    }
  }
  AT_STORE(0);
  __syncthreads();
  bool wave_done = false;
  for (int it = 0; it < np2; ++it) {
    const int buf = it & 1;
    if (it > 0) {
      const volatile int* f = dflag + ((it - 1) & 1) * 8;
      if (f[0] & f[1] & f[2] & f[3] & f[4] & f[5] & f[6] & f[7]) break;
    }
    if (it + 1 < np2) AT_LOAD(np2 - 2 - it);
#pragma unroll
    for (int sb = 0; sb < 2; ++sb) {
    const int ti = 2 * (np2 - 1 - it) + 1 - sb; const int k0 = ti * 64; const bool last_tile = (ti == 0);
    if (k0 <= qmax_w && !wave_done) {
      const bf16_t* Kb = K_s + (buf * 2 + sb) * 8704; const bf16_t* Vb = V_s + (buf * 2 + sb) * 9216;
      f32x4 s[4];
#pragma unroll
      for (int kt = 0; kt < 4; ++kt) {
        s[kt] = (f32x4){0.f, 0.f, 0.f, 0.f};
#pragma unroll
        for (int kk = 0; kk < 4; ++kk) s[kt] = MFMA16(*(const bf16x8*)(Kb + (kt * 16 + fr) * 136 + fq * 8 + 32 * kk), qf[kk], s[kt]);
      }
      bf16x8 pf[2];
      if (!SBK) {
        float mx = -INFINITY;
        const bool need_mask = (k0 + 63 > qmin_w);
#pragma unroll
        for (int kt = 0; kt < 4; ++kt) {
          const float4 cv = *(const float4*)(ck_s + (buf * 2 + sb) * 64 + kt * 16 + fq * 4);
          const float cc[4] = {cv.x, cv.y, cv.z, cv.w};
#pragma unroll
          for (int j = 0; j < 4; ++j) { float v = s[kt][j] - cc[j]; if (need_mask) { const int key = k0 + kt * 16 + fq * 4 + j; v = (key <= q) ? v : -INFINITY; } s[kt][j] = v; mx = fmaxf(mx, v); }
        }
        mx = fmaxf(mx, __shfl_xor(mx, 16)); mx = fmaxf(mx, __shfl_xor(mx, 32));
        if (__any(mx > m_run)) {
          const float m_new = fmaxf(m_run, mx);
          const float alpha = __expf(m_run - m_new);
          m_run = m_new;
          l_run *= alpha;
#pragma unroll
          for (int dt = 0; dt < 8; ++dt) acc_o[dt] = acc_o[dt] * alpha;
        }
        float ps = 0.f;
#pragma unroll
        for (int kt = 0; kt < 4; ++kt)
#pragma unroll
          for (int j = 0; j < 4; ++j) { const float p = __expf(s[kt][j] - m_run); s[kt][j] = p; ps += p; }
        l_run += ps;
        if (!last_tile) { const float cnext = (sb == 0) ? ck_s[(buf * 2 + 1) * 64 + 63] : rcn; wave_done = __all(zmax - cnext - m_run < -110.f) != 0; }
      } else {
        float lsig[4][4];
        bf16x8 lf[2];
#pragma unroll
        for (int kt = 0; kt < 4; ++kt)
#pragma unroll
          for (int j = 0; j < 4; ++j) {
            const int key = k0 + kt * 16 + fq * 4 + j; const float z = s[kt][j]; const float sp = softplus_(z);
            lsig[kt][j] = z - sp; s[kt][j] = (key < q) ? -sp : 0.f;
          }
#pragma unroll
        for (int g = 0; g < 2; ++g) { u32x4 w; w.x = pk2(s[2 * g][0], s[2 * g][1]); w.y = pk2(s[2 * g][2], s[2 * g][3]); w.z = pk2(s[2 * g + 1][0], s[2 * g + 1][1]); w.w = pk2(s[2 * g + 1][2], s[2 * g + 1][3]); lf[g] = __builtin_bit_cast(bf16x8, w); }
        f32x4 tl[4], tot;
        const f32x4 zero4 = {0.f, 0.f, 0.f, 0.f};
        tl[0] = MFMA16(Ue, lf[0], zero4); tl[0] = MFMA16(U1, lf[1], tl[0]);
        tl[1] = MFMA16(Uo, lf[0], zero4); tl[1] = MFMA16(U1, lf[1], tl[1]);
        tl[2] = MFMA16(Ue, lf[1], zero4);
        tl[3] = MFMA16(Uo, lf[1], zero4);
        tot = MFMA16(U1, lf[0], zero4); tot = MFMA16(U1, lf[1], tot);
#pragma unroll
        for (int kt = 0; kt < 4; ++kt)
#pragma unroll
          for (int j = 0; j < 4; ++j) { const int key = k0 + kt * 16 + fq * 4 + j; s[kt][j] = (key < q) ? __expf(lsig[kt][j] + tl[kt][j] + R) : 0.f; }
        R += tot[0];
        wave_done = __all(R < -110.f) != 0;
      }
#pragma unroll
      for (int g = 0; g < 2; ++g) { u32x4 w; w.x = pk2(s[2 * g][0], s[2 * g][1]); w.y = pk2(s[2 * g][2], s[2 * g][3]); w.z = pk2(s[2 * g + 1][0], s[2 * g + 1][1]); w.w = pk2(s[2 * g + 1][2], s[2 * g + 1][3]); pf[g] = __builtin_bit_cast(bf16x8, w); }
#pragma unroll
      for (int dt = 0; dt < 8; ++dt)
#pragma unroll
        for (int g = 0; g < 2; ++g) {
          const bf16_t* vp = Vb + (dt * 16 + fr) * 72 + 32 * g + fq * 4;
          u32x4 a; const u32x2 a0 = *(const u32x2*)vp, a1 = *(const u32x2*)(vp + 16);
          a.x = a0.x; a.y = a0.y; a.z = a1.x; a.w = a1.y;
          acc_o[dt] = MFMA16(__builtin_bit_cast(bf16x8, a), pf[g], acc_o[dt]);
        }
    }
    }
    if (it + 1 < np2) AT_STORE(buf ^ 1);
    if (lane == 0) dflag[(it & 1) * 8 + wave] = wave_done ? 1 : 0;
    __syncthreads();
  }
#undef AT_LOAD
#undef AT_STORE
  {
    float inv = 1.f;
    if (!SBK) { float l = l_run; l += __shfl_xor(l, 16); l += __shfl_xor(l, 32); inv = 1.f / l; }
    bf16_t* op = P.O + (size_t)(tb + q) * 1024 + h * 128 + fq * 4;
#pragma unroll
    for (int dt = 0; dt < 8; ++dt) {
      float o0 = acc_o[dt][0] * inv, o1 = acc_o[dt][1] * inv, o2 = acc_o[dt][2] * inv, o3 = acc_o[dt][3] * inv;
      if (!SBK) {
        const u32x2 gv = *(const u32x2*)(P.gate + (size_t)(tb + q) * ld + h * 128 + dt * 16 + fq * 4);
        o0 *= sigmoid_(bflo(gv.x)); o1 *= sigmoid_(bfhi(gv.x)); o2 *= sigmoid_(bflo(gv.y)); o3 *= sigmoid_(bfhi(gv.y));
      }
      u32x2 p; p.x = pk2(o0, o1); p.y = pk2(o2, o3);
      *(u32x2*)(op + dt * 16) = p;
    }
  }
}

__device__ __forceinline__ void fox_knorm(bf16_t* Kb  , const float* kg) {
  const int tid = tid_fresh();
  const int seg = tid & 15;
  float g[8];
#pragma unroll
  for (int e = 0; e < 8; ++e) g[e] = kg[seg * 8 + e];
  for (int it = blockIdx.x * 32 + (tid >> 4); it < T * 4; it += gridDim.x * 32) {
    const int t = it >> 2, h = it & 3;
    bf16_t* p = Kb + (size_t)t * 3584 + h * 128 + seg * 8;
    u32x4 x = *(const u32x4*)p;
    float v[8]; v[0] = bflo(x.x); v[1] = bfhi(x.x); v[2] = bflo(x.y); v[3] = bfhi(x.y); v[4] = bflo(x.z); v[5] = bfhi(x.z); v[6] = bflo(x.w); v[7] = bfhi(x.w);
    float ss = 0.f;
#pragma unroll
    for (int e = 0; e < 8; ++e) ss += v[e] * v[e];
    ss += __shfl_xor(ss, 1); ss += __shfl_xor(ss, 2); ss += __shfl_xor(ss, 4); ss += __shfl_xor(ss, 8);
    const float r = rsqrtf(ss * (1.f / 128.f) + EPS);
    x.x = pk2(v[0] * r * g[0], v[1] * r * g[1]); x.y = pk2(v[2] * r * g[2], v[3] * r * g[3]); x.z = pk2(v[4] * r * g[4], v[5] * r * g[5]); x.w = pk2(v[6] * r * g[6], v[7] * r * g[7]);
    *(u32x4*)p = x;
  }
}

#ifndef NREP_G
#define NREP_G 1
#endif
#ifndef REP_MODE
#define REP_MODE -1
#endif
#ifndef NREP_N
#define NREP_N 1
#endif
#ifndef NREP_P
#define NREP_P 1
#endif
#ifndef NREP_S
#define NREP_S 1
#endif
#ifndef NREP_F
#define NREP_F 1
#endif
#ifndef NREP_B
#define NREP_B 1
#endif


#define WSP(T_, off) ((T_*)(ws + (off)))
#define GRID_BAR() do { XcdBarrier b_; b_.bar = (unsigned*)(fresh_args()->ws + WS_BAR); b_.x = xb_xcc_id(); b_.st = (volatile LAS unsigned*)(glds + 151 * 1024); xcd_barrier(b_); } while (0)

#ifdef DEBUG_NAN
__device__ __forceinline__ void chk_words(const unsigned* p, size_t nwords, bool bf, unsigned* err, unsigned code) {
  bool bad = false, nan = false;
  for (size_t i = ((size_t)blockIdx.x * 512 + threadIdx.x); i < nwords; i += (size_t)gridDim.x * 512) {
    const unsigned w = p[i];
    if ((w & 0x7F800000u) >= (141u << 23)) bad = true;
    if ((w & 0x7F800000u) == 0x7F800000u) nan = true;
    if (bf && (w & 0x7F80u) >= (141u << 7)) bad = true;
    if (bf && (w & 0x7F80u) == 0x7F80u) nan = true;
  }
  if (bad) atomicCAS(err, 0u, code);
  if (nan) atomicCAS(err + 1, 0u, code);
}
#endif

__global__ void __launch_bounds__(512, 2) fwd_megakernel(Args a_unused) {
  extern __shared__ __attribute__((aligned(16))) unsigned char lds[];
  cg::grid_group grid = cg::this_grid();
  PG8_LAS unsigned char* glds = (PG8_LAS unsigned char*)lds;
  const int G = gridDim.x, bid = blockIdx.x;
  asm volatile("s_nop 0");
  asm volatile("s_nop 0");
  asm volatile("s_nop 0");
  asm volatile("s_nop 0");
  if (threadIdx.x < 4) ((volatile LAS unsigned*)(glds + 151 * 1024))[threadIdx.x] = 0u;
  __syncthreads();
  (void)xcd_barrier_post((unsigned*)(fresh_args()->ws + WS_BAR), (volatile LAS unsigned*)(glds + 151 * 1024));
  grid.sync();

  for (int step = 0; step < 8; ++step) {
    const int l = step >> 1, which = step & 1, j = l >> 1; const bool even = (l & 1) == 0;
    const int np = which ? 3 : 10;
    const int nmain = even ? 3584 : 2048, nv = even ? 512 : 1024;
    for (int p = 0; p < np; ++p) {
      if ((p == 6 || p == 8) && !even) continue;
      if (p == 3 || (p == 0 && which == 1)) continue;
      if (p == 1 || p == 2 || p == 4 || p == 5 || p == 9) {
        ArgsP a = fresh_args(); unsigned char* ws = a->ws;
        const bf16_t* gA; const bf16_t* gB; int gM, gN, gK, emode, eldc; void* eP; float escale; int oid = bid;
        if (p == 1) { gA = WSP(bf16_t, WS_XN); gB = which ? WSP(bf16_t, WS_GU2) : WSP(bf16_t, WS_GU1); gM = T; gN = 5632; gK = 1024; emode = 0; eP = WSP(void, WS_BIG); eldc = FF; escale = 0.f; }
        else if (p == 2) { gA = WSP(bf16_t, WS_BIG); gB = which ? WSP(bf16_t, WS_DN2) : WSP(bf16_t, WS_DN1); gM = T; gN = 1024; gK = FF; emode = 1; eP = a->out; eldc = 1024; escale = 0.5f; }
        else if (p == 4) { gA = WSP(bf16_t, WS_XN); gB = WSP(bf16_t, WS_WIN); gM = T; gN = nmain; gK = 1024; emode = 2; eP = WSP(void, WS_BIG); eldc = nmain; escale = 0.f;
                           if (even) norm_phase<true>(lds, a->out, nullptr, a->in[4] + l * 1024, nullptr, a->in[5] + (size_t)j * 1024 * 4108, a->in[7] + j * 4, a->in[8] + j * 4, a->in[12] + j * 4, WSP(float, WS_SM)); }
        else if (p == 5) { gA = WSP(bf16_t, WS_WIN) + (size_t)nmain * 1024; gB = WSP(bf16_t, WS_XN); gM = nv; gN = T; gK = 1024; emode = 3; eP = WSP(void, WS_VT); eldc = T; escale = 0.f; if (even) oid = (bid + G / 2) % G; }
        else { gA = WSP(bf16_t, WS_OB); gB = WSP(bf16_t, WS_WOUT); gM = T; gN = 1024; gK = 1024; emode = 1; eP = a->out; eldc = 1024; escale = 1.0f; }
        const pg8::Gemm g{gA, gB, gM, gN, gK};
        const EpiAny E{emode, eP, eldc, escale};
        pg8::StaticOrder S; S.init(g.M, g.N, G, oid);
#ifndef NO_G
#if NREP_G > 1
        for (int rep = 0; rep < ((REP_MODE < 0 || emode == REP_MODE) ? NREP_G : 1); ++rep) { EpiAny Er = E; if (rep + 1 < ((REP_MODE < 0 || emode == REP_MODE) ? NREP_G : 1)) Er.scale = 0.f; pg8::gemm_phase<EpiAny, pg8::StaticOrder>(glds, g, S, Er, nullptr); }
#else
        pg8::gemm_phase<EpiAny, pg8::StaticOrder>(glds, g, S, E, nullptr);
#endif
#endif
        if (p == 4) continue;
      } else if (p == 0) {
        for (int rep = 0; rep < NREP_N; ++rep) {
        ArgsP a = fresh_args(); unsigned char* ws = a->ws;
        convert_layer((float*)lds, even, l, j, a, ws);
        if (step == 0) init_phase(a->in[0], a->out, WSP(bf16_t, WS_XN), WSP(float, WS_PS));
        }
      } else if (p == 6) {
#ifndef NO_PREP
        ArgsP a = fresh_args(); unsigned char* ws = a->ws;
        cumsum_logf(lds, WSP(float, WS_SM), WSP(float, WS_CF));
        fox_knorm(WSP(bf16_t, WS_BIG) + 2560, a->in[11] + j * 128);
        for (int rep = 0; rep < NREP_P; ++rep) for (int u = bid; u < 1024; u += G) dn_prep_unit(lds, u, WSP(bf16_t, WS_BIG), WSP(float, WS_SM), a->in[6] + (size_t)j * 4 * 1536, ws + WS_DNX, WSP(float, WS_GL));
#endif
      } else if (p == 8) {
        ArgsP a = fresh_args(); unsigned char* ws = a->ws;
        dn_fixup(WSP(float, WS_OF), WSP(float, WS_PSD), WSP(bf16_t, WS_BIG), a->in[9] + j * 128, WSP(bf16_t, WS_OB));
      } else if (p == 7) {
        if (even) {
#ifndef NO_SCAN
          if (bid < 64) for (int rep = 0; rep < NREP_S; ++rep) { ArgsP a = fresh_args(); unsigned char* ws = a->ws; dn_scan(lds, bid, ws + WS_DNX, WSP(float, WS_GL), WSP(float, WS_OF), WSP(float, WS_PSD)); }
#endif
          ArgsP a = fresh_args(); unsigned char* ws = a->ws;
          int* qslot = (int*)(lds + 150 * 1024);
          AttnP P; P.Q = WSP(bf16_t, WS_BIG) + 2048; P.K = WSP(bf16_t, WS_BIG) + 2560; P.ld = 3584; P.VT = WSP(bf16_t, WS_VT); P.qg = a->in[10] + j * 128; P.kg = a->in[11] + j * 128;
          P.CF = WSP(float, WS_CF); P.gate = WSP(bf16_t, WS_BIG) + 3072; P.O = WSP(bf16_t, WS_OB) + 512; P.H = 4;
          for (int rep = 0; rep < NREP_F; ++rep) {
          unsigned* ctr = WSP(unsigned, WS_CTL) + l + 8 * rep;
          for (;;) {
            if (threadIdx.x == 0) *qslot = (int)atomicAdd(ctr, 1u);
            __syncthreads();
            const int unit = *qslot;
            __syncthreads();
            if (unit >= 512) break;
#ifndef NO_FOX
            attn_unit<false>(lds, P, unit & 15, 31 - (unit >> 4));
#endif
          }
          }
        } else {
          ArgsP a = fresh_args(); unsigned char* ws = a->ws;
          int* qslot = (int*)(lds + 150 * 1024);
          AttnP P; P.Q = WSP(bf16_t, WS_BIG); P.K = WSP(bf16_t, WS_BIG) + 1024; P.ld = 2048; P.VT = WSP(bf16_t, WS_VT); P.qg = nullptr; P.kg = nullptr; P.CF = nullptr; P.gate = nullptr; P.O = WSP(bf16_t, WS_OB); P.H = 8;
          for (int rep = 0; rep < NREP_B; ++rep) {
          unsigned* ctr = WSP(unsigned, WS_CTL) + l + 8 * rep;
          for (;;) {
            if (threadIdx.x == 0) *qslot = (int)atomicAdd(ctr, 1u);
            __syncthreads();
            const int unit = *qslot;
            __syncthreads();
            if (unit >= 1024) break;
#ifndef NO_SB
            attn_unit<true>(lds, P, unit & 31, 31 - (unit >> 5));
#endif
          }
          }
        }
      }
      GRID_BAR();
#ifdef NREP_Y
      GRID_BAR();
#endif
#ifdef DEBUG_NAN
      {
        ArgsP a = fresh_args(); unsigned* err = (unsigned*)(a->ws + WS_CTL) + 64; const unsigned code = (unsigned)(step * 10 + p + 1);
        const unsigned* cp = nullptr; size_t nw = 0; bool bf = true;
        if (p == 0 || p == 3) { cp = (const unsigned*)(a->ws + WS_XN); nw = (size_t)T * 512; }
        if (p == 1) { cp = (const unsigned*)(a->ws + WS_BIG); nw = (size_t)T * FF / 2; }
        if (p == 2 || p == 8) { cp = (const unsigned*)a->out; nw = (size_t)T * 1024; bf = false; }
        if (p == 5) { cp = (const unsigned*)(a->ws + WS_BIG); nw = (size_t)T * nmain / 2; }
        if (p == 6) { cp = (const unsigned*)(a->ws + WS_DNX); nw = (size_t)1024 * DNX_UNIT / 4; }
        if (p == 7) { cp = (const unsigned*)(a->ws + WS_OB); nw = (size_t)T * 512; }
        chk_words(cp, nw, bf, err, code);
        if (p == 5) chk_words((const unsigned*)(a->ws + WS_VT), (size_t)T * nv / 2, true, err, 90u + (unsigned)step);
      }
#endif
    }
  }
#ifdef DEBUG_NAN
  {
    ArgsP a = fresh_args(); float* X = a->out; const unsigned err = *((volatile unsigned*)(a->ws + WS_CTL) + 64), errn = *((volatile unsigned*)(a->ws + WS_CTL) + 65);
    for (size_t i = ((size_t)blockIdx.x * 512 + threadIdx.x); i < (size_t)T * 1024; i += (size_t)gridDim.x * 512) {
      X[i] = (i == 5 && (err | errn)) ? (errn ? 100.f * (float)errn : (float)err) : 0.f;
    }
  }
#endif
}

extern "C" void kernel_launch(void* const* d_in, const int* in_sizes, int n_in,
                              void* d_out, int out_size, void* d_ws, size_t ws_size,
                              hipStream_t stream) {
  static int grid = 0;
  if (grid == 0) {
    int dev = 0, cus = 0, per_cu = 0;
    (void)hipGetDevice(&dev);
    (void)hipDeviceGetAttribute(&cus, hipDeviceAttributeMultiprocessorCount, dev);
    (void)hipFuncSetAttribute((const void*)fwd_megakernel, hipFuncAttributeMaxDynamicSharedMemorySize, LDS_BYTES);
    (void)hipOccupancyMaxActiveBlocksPerMultiprocessor(&per_cu, (const void*)fwd_megakernel, 512, LDS_BYTES);
    (void)hipGetLastError();
    grid = cus > 0 ? cus : 256;
    if (ws_size < WS_END || n_in != 19) { fprintf(stderr, "kernel_launch: ws %zu < %zu or n_in %d\n", ws_size, (size_t)WS_END, n_in); grid = -1; }
    fprintf(stderr, "kernel_launch: cus %d per_cu %d grid %d ws %zu need %zu\n", cus, per_cu, grid, ws_size, (size_t)WS_END);
  }
  if (grid < 0) return;
  (void)hipMemsetAsync((char*)d_ws + WS_CTL, 0, CTL_BYTES, stream);
  Args a{};
  for (int i = 0; i < 19; ++i) a.in[i] = (const float*)d_in[i];
  a.out = (float*)d_out; a.ws = (unsigned char*)d_ws;
  void* args[] = {&a};
  hipError_t e = hipLaunchCooperativeKernel((const void*)fwd_megakernel, dim3(grid), dim3(512), args, LDS_BYTES, stream);
  if (e != hipSuccess) fprintf(stderr, "cooperative launch failed: %s (grid %d)\n", hipGetErrorString(e), grid);
}
```

```cpp
#include <hip/hip_runtime.h>
#include <hip/hip_cooperative_groups.h>
#include <cstdio>
namespace cg = cooperative_groups;
__device__ __forceinline__ int tid_fresh() { int t = threadIdx.x; asm volatile("" : "+v"(t)); return t; }
namespace pg8 {
#define PG8_LAS __attribute__((address_space(3)))
typedef unsigned short bf16_t;
typedef short bf16x8 __attribute__((ext_vector_type(8)));
typedef float f32x4 __attribute__((ext_vector_type(4)));
typedef unsigned u32x4 __attribute__((ext_vector_type(4)));
constexpr int BM = 256, BK = 64, HALF = 128, HTB = HALF * BK * 2  , STAGE_BYTES = 8 * HTB, NXCD = 8, WGM = 8;

__host__ __device__ __forceinline__ int lds_byte(int r, int c) { const int st = (r >> 4) * 2 + (c >> 5), rr = r & 15, cc = c & 31, ob = rr * 64 + cc * 2; return st * 1024 + (ob ^ (((ob >> 9) & 1) << 5)); }
__host__ __device__ __forceinline__ void stage_rc(int b, int& R, int& C) { const int st = b / 1024, sb = b % 1024, swz = sb ^ (((sb >> 9) & 1) << 5); R = (st >> 1) * 16 + swz / 64; C = (st & 1) * 32 + (swz % 64) / 2; }
__host__ __device__ __forceinline__ int perm32(int rho) { const int n = rho >> 4, i = rho & 15; return 8 * (i >> 2) + 4 * n + (i & 3); }

struct Unit { int pm, pn; };
struct Gemm { const bf16_t* A; const bf16_t* Bt; int M, N, K; };

struct StaticOrder {
    int nM, nN, nwg, G, c;
    __host__ __device__ void init(int M, int N, int G_, int c_) { nM = M / BM; nN = N / BM; nwg = nM * nN; G = G_; c = c_; }
    __host__ __device__ bool next(int i, Unit& u) const {
        const long L = (long)i * G + c; if (L >= nwg) return false;
        int wgid = (int)L; { const int q = nwg / NXCD, r = nwg % NXCD, xcd = wgid % NXCD, off = wgid / NXCD; wgid = (xcd < r ? xcd * (q + 1) : r * (q + 1) + (xcd - r) * q) + off; }
        const int nig = WGM * nN, gid = wgid / nig, fm = gid * WGM, gsz = (nM - fm) < WGM ? (nM - fm) : WGM;
        u.pm = fm + ((wgid % nig) % gsz); u.pn = (wgid % nig) / gsz; return true;
    }
    __device__ __forceinline__ void a_ready(const Unit&) const {}
    __device__ __forceinline__ void done(const Unit&) const {}
};
struct CountedOrder : StaticOrder {
    const unsigned* ready; unsigned need; unsigned* tmo;
    __device__ __forceinline__ void a_ready(const Unit& u) const {
        if (threadIdx.x < 64) {
            const unsigned long long t0 = __builtin_amdgcn_s_memrealtime(); unsigned polls = 0;
            while ((unsigned)__builtin_amdgcn_readfirstlane(__hip_atomic_load(ready + 64 * u.pm, __ATOMIC_RELAXED, __HIP_MEMORY_SCOPE_AGENT)) < need) {
                if ((++polls & 255u) == 0u && __builtin_amdgcn_readfirstlane(__hip_atomic_load(tmo, __ATOMIC_RELAXED, __HIP_MEMORY_SCOPE_AGENT)) != 0u) break;
                if (__builtin_amdgcn_s_memrealtime() - t0 > 2000000ull) {
                    if (threadIdx.x == 0) { unsigned expect = 0u; __hip_atomic_compare_exchange_strong(tmo + 1, &expect, 0x600u | (unsigned)(u.pm & 0xff), __ATOMIC_RELAXED, __ATOMIC_RELAXED, __HIP_MEMORY_SCOPE_AGENT); __hip_atomic_store(tmo, 1u, __ATOMIC_RELAXED, __HIP_MEMORY_SCOPE_AGENT); }
                    break; }
                __builtin_amdgcn_s_sleep(2); }
            __builtin_amdgcn_fence(__ATOMIC_ACQUIRE, "agent");
            asm volatile("s_waitcnt vmcnt(0)" ::: "memory");
        }
#if !defined(BROKEN_HOOK_NO_BARRIER)
        asm volatile("" ::: "memory"); __builtin_amdgcn_s_barrier(); asm volatile("" ::: "memory");
#endif
    }
};

__device__ __forceinline__ unsigned cvt_pk_bf16(float lo, float hi) { unsigned r; asm volatile("v_cvt_pk_bf16_f32 %0, %1, %2" : "=v"(r) : "v"(lo), "v"(hi)); return r; }

template <class Epi, class Sched, bool STAMP = false>
__device__ __forceinline__ void gemm_phase(PG8_LAS unsigned char* lds, const Gemm g, const Sched& S, const Epi& E, unsigned long long* stamps) {
    const int tid = tid_fresh(), wid = __builtin_amdgcn_readfirstlane(tid >> 6), lane = tid & 63, wr = wid >> 2, wc = wid & 3, fr = lane & 15, fq = lane >> 4;
    const int K = g.K, nt = K / BK;
    int ts_lo = 0, ts_hi = 0, nts = 0; const unsigned long long rt_entry = STAMP ? (unsigned long long)wall_clock64() : 0ull;
#define PG8_STAMP() do { if (STAMP && wid == 0 && nts < 64) { const unsigned long long _c = (unsigned long long)clock64(); \
        ts_lo = (lane == nts) ? (int)(unsigned)_c : ts_lo; ts_hi = (lane == nts) ? (int)(unsigned)(_c >> 32) : ts_hi; ++nts; } } while (0)
    PG8_STAMP();
    unsigned voffA[2], voffB[2];
#pragma unroll
    for (int i = 0; i < 2; ++i) { int R, C; stage_rc(tid * 16 + i * 8192, R, C); const int Rb = E.perm() ? ((R & ~31) + perm32(R & 31)) : R;
        voffA[i] = (unsigned)(R * K + C) * 2u; voffB[i] = (unsigned)(Rb * K + C) * 2u; }
    const size_t kstep = (size_t)(BK * 2);
    const size_t hstep = (size_t)HALF * K * 2;
    const size_t tstep = 2 * hstep;
    const unsigned ldsw = (unsigned)wid * 1024u;
    const int aoff = lds_byte(wr * 64 + fr, fq * 8), boff = lds_byte(wc * 32 + fr, fq * 8);
#define PG8_SA(b, h) (((b) * 2 + (h)) * HTB)
#define PG8_SB(b, h) ((4 + (b) * 2 + (h)) * HTB)
#define PG8_STAGE(bufoff, gbase, voff) do { _Pragma("unroll") for (int _i = 0; _i < 2; ++_i) \
        __builtin_amdgcn_global_load_lds((const unsigned*)((const char*)(gbase) + (voff)[_i]), (PG8_LAS unsigned*)(lds + (bufoff) + ldsw + _i * 8192), 16, 0, 0); } while (0)
#define PG8_LDA(dst, b, h) do { _Pragma("unroll") for (int m = 0; m < 4; ++m) _Pragma("unroll") for (int k = 0; k < 2; ++k) dst[m][k] = *(const PG8_LAS bf16x8*)(lds + PG8_SA(b, h) + aoff + m * 2048 + k * 1024); } while (0)
#define PG8_LDB(dst, b, h) do { _Pragma("unroll") for (int n = 0; n < 2; ++n) _Pragma("unroll") for (int k = 0; k < 2; ++k) dst[n][k] = *(const PG8_LAS bf16x8*)(lds + PG8_SB(b, h) + boff + n * 2048 + k * 1024); } while (0)
#define PG8_MMA(ai, bj, At, Bt) do { __builtin_amdgcn_s_setprio(1); _Pragma("unroll") for (int m = 0; m < 4; ++m) _Pragma("unroll") for (int n = 0; n < 2; ++n) _Pragma("unroll") for (int k = 0; k < 2; ++k) \
        acc[ai][bj][m][n] = __builtin_amdgcn_mfma_f32_16x16x32_bf16(Bt[n][k], At[m][k], acc[ai][bj][m][n], 0, 0, 0); __builtin_amdgcn_s_setprio(0); } while (0)
#define PG8_WAIT_V(n) asm volatile("s_waitcnt vmcnt(" #n ")" ::: "memory")
#define PG8_WAIT_L(n) asm volatile("s_waitcnt lgkmcnt(" #n ")" ::: "memory")
#define PG8_BAR __builtin_amdgcn_s_barrier()
#define PG8_SCHED __builtin_amdgcn_sched_barrier(0)
    Unit cur, nxt; int ui = 0;
    if (!S.next(0, cur)) return;
    f32x4 acc[2][2][4][2];
    E.init(acc, cur, wr, wc, fr, fq);
    bf16x8 At[4][2], B0[2][2], B1[2][2];
    const char* cA = (const char*)g.A + (size_t)cur.pm * tstep; const char* cB = (const char*)g.Bt + (size_t)cur.pn * tstep;
    S.a_ready(cur);
    PG8_STAGE(PG8_SB(0, 0), cB, voffB); PG8_STAGE(PG8_SA(0, 0), cA, voffA); PG8_STAGE(PG8_SB(0, 1), cB + hstep, voffB); PG8_STAGE(PG8_SA(0, 1), cA + hstep, voffA);
    E.prepare(S, tid);
    if (wr == 1) PG8_BAR;
    PG8_WAIT_V(4); PG8_BAR;
    PG8_STAGE(PG8_SB(1, 0), cB + kstep, voffB); PG8_STAGE(PG8_SA(1, 0), cA + kstep, voffA); PG8_STAGE(PG8_SB(1, 1), cB + hstep + kstep, voffB);
    PG8_WAIT_V(6); PG8_BAR;
    PG8_STAMP();
    for (;;) {
        const bool has_next = S.next(ui + 1, nxt);
        const char* nA = has_next ? (const char*)g.A + (size_t)nxt.pm * tstep : cA; const char* nB = has_next ? (const char*)g.Bt + (size_t)nxt.pn * tstep : cB;
        for (int t = 0; t < nt; t += 2) {
            const bool last = (t == nt - 2);
            const char* a1 = cA + (size_t)(t + 1) * kstep;
            const char* a2 = last ? nA : cA + (size_t)(t + 2) * kstep; const char* b2 = last ? nB : cB + (size_t)(t + 2) * kstep;
            const char* a3 = a2 + kstep; const char* b3 = b2 + kstep;
            if (last && has_next) S.a_ready(nxt);
            PG8_LDB(B0, 0, 0); PG8_SCHED; PG8_LDA(At, 0, 0); PG8_STAGE(PG8_SA(1, 1), a1 + hstep, voffA);
            PG8_WAIT_L(8); PG8_BAR; PG8_WAIT_L(0); PG8_MMA(0, 0, At, B0); PG8_BAR; PG8_SCHED;
            PG8_LDB(B1, 0, 1); PG8_STAGE(PG8_SB(0, 0), b2, voffB);
            PG8_BAR; PG8_WAIT_L(0); PG8_MMA(0, 1, At, B1); PG8_BAR;
            PG8_LDA(At, 0, 1); PG8_STAGE(PG8_SA(0, 0), a2, voffA);
            PG8_BAR; PG8_WAIT_L(0); PG8_MMA(1, 0, At, B0); PG8_BAR; PG8_SCHED;
            PG8_STAGE(PG8_SB(0, 1), b2 + hstep, voffB);
            PG8_WAIT_V(6); PG8_BAR; PG8_MMA(1, 1, At, B1); PG8_BAR;
            PG8_LDB(B0, 1, 0); PG8_SCHED; PG8_LDA(At, 1, 0); PG8_STAGE(PG8_SA(0, 1), a2 + hstep, voffA);
            PG8_WAIT_L(8); PG8_BAR; PG8_WAIT_L(0); PG8_MMA(0, 0, At, B0); PG8_BAR; PG8_SCHED;
            PG8_LDB(B1, 1, 1); PG8_STAGE(PG8_SB(1, 0), b3, voffB);
            PG8_BAR; PG8_WAIT_L(0); PG8_MMA(0, 1, At, B1); PG8_BAR;
            PG8_LDA(At, 1, 1); PG8_STAGE(PG8_SA(1, 0), a3, voffA);
            PG8_BAR; PG8_WAIT_L(0); PG8_MMA(1, 0, At, B0); PG8_BAR; PG8_SCHED;
            PG8_STAGE(PG8_SB(1, 1), b3 + hstep, voffB);
            PG8_WAIT_V(6); PG8_BAR; PG8_MMA(1, 1, At, B1); PG8_BAR;
        }
        PG8_STAMP();
        if constexpr (!Epi::AFTER_DRAIN) { E(acc, cur, wr, wc, fr, fq, ui);
#ifdef NREP_E
            if (E.perm()) E(acc, cur, wr, wc, fr, fq, ui);
#endif
            S.done(cur); }
        PG8_STAMP();
        if (!has_next) break;
        E.init(acc, nxt, wr, wc, fr, fq);
        cur = nxt; cA = nA; cB = nB; ++ui;
    }
    PG8_WAIT_V(0);
    if (wr == 0) PG8_BAR;
    PG8_BAR;
    if constexpr (Epi::AFTER_DRAIN) { E.fused(acc, cur, wr, wc, fr, fq, lds, wid, lane); S.done(cur); }
    PG8_STAMP();
    if (STAMP && wid == 0) { stamps[lane] = lane < nts ? (((unsigned long long)(unsigned)ts_hi << 32) | (unsigned)ts_lo) : 0ull;
        if (lane == 62) stamps[62] = rt_entry; if (lane == 63) stamps[63] = (unsigned long long)wall_clock64(); }
#undef PG8_STAMP
#undef PG8_SA
#undef PG8_SB
#undef PG8_STAGE
#undef PG8_LDA
#undef PG8_LDB
#undef PG8_MMA
#undef PG8_WAIT_V
#undef PG8_WAIT_L
#undef PG8_BAR
#undef PG8_SCHED
}
}
#define XB_TMO      128
#define XB_XCNT(j)  (256  + 64 * (j))
#define XB_XSUB(j)  (1280 + 64 * (j))
#define XB_XGEN(j)  (2304 + 64 * (j))
#define XB_TOP      3328
#define XB_TOPGEN   3392
#define XCD_BAR_WORDS 3456
#define XB_SPIN_CAP (1u << 18)
#ifndef LAS
#define LAS __attribute__((address_space(3)))
#endif

__device__ __forceinline__ unsigned xb_ld(unsigned* p)              { return __hip_atomic_load(p, __ATOMIC_RELAXED, __HIP_MEMORY_SCOPE_AGENT); }
__device__ __forceinline__ unsigned xb_add(unsigned* p, unsigned v) { return __hip_atomic_fetch_add(p, v, __ATOMIC_RELAXED, __HIP_MEMORY_SCOPE_AGENT); }
__device__ __forceinline__ unsigned xb_xcc_id() { return (unsigned)__builtin_amdgcn_s_getreg((3 << 11) | 20) & 0xFu; }
#define XB_SPIN(cond, bar) do { unsigned _sp = 0; while (cond) { __builtin_amdgcn_s_sleep(1); \
    if ((++_sp & 255u) == 0u) { if (xb_ld(&(bar)[XB_TMO])) break; if (_sp > XB_SPIN_CAP) { atomicAdd(&(bar)[XB_TMO], 1u); break; } } } } while (0)

struct XcdBarrier {
    unsigned* bar; unsigned x;
    volatile LAS unsigned* st;
};

__device__ __forceinline__ XcdBarrier xcd_barrier_post(unsigned* bar, volatile LAS unsigned* st) {
    XcdBarrier b; b.bar = bar; b.x = xb_xcc_id(); b.st = st;
    if (threadIdx.x == 0) (void)xb_add(&bar[XB_XCNT(b.x)], 1u);
    return b;
}
__device__ __forceinline__ void xcd_barrier_complete(unsigned* bar, unsigned x, unsigned& nloc, unsigned& nx) {
    const unsigned G = gridDim.x * gridDim.y * gridDim.z;
    unsigned sum, cnt, mine, sp = 0u;
    for (;;) {
        sum = 0u; cnt = 0u; mine = 0u;
#pragma unroll
        for (unsigned j = 0; j < 16; ++j) { const unsigned c = xb_ld(&bar[XB_XCNT(j)]); sum += c; cnt += (c > 0u) ? 1u : 0u; mine = (j == x) ? c : mine; }
        if (sum == G) break;
        __builtin_amdgcn_s_sleep(1);
        if ((++sp & 255u) == 0u) { if (xb_ld(&bar[XB_TMO])) break; if (sp > XB_SPIN_CAP) { atomicAdd(&bar[XB_TMO], 1u); break; } }
    }
    nloc = mine > 0u ? mine : 1u; nx = cnt > 0u ? cnt : 1u;
}

__device__ __forceinline__ void xcd_barrier(const XcdBarrier& b) {
    asm volatile("s_waitcnt vmcnt(0)" ::: "memory");
    __syncthreads();
    if (threadIdx.x == 0) {
        unsigned* bar = b.bar;
        __builtin_amdgcn_s_waitcnt(0);
        unsigned nloc = b.st[0], nx = b.st[1];
        if (nloc == 0u) { xcd_barrier_complete(bar, b.x, nloc, nx); b.st[0] = nloc; b.st[1] = nx; }
        const unsigned old = xb_add(&bar[XB_XSUB(b.x)], 1u);
        const unsigned gen = old / nloc;
        if (old + 1u == (gen + 1u) * nloc) {
            __builtin_amdgcn_fence(__ATOMIC_RELEASE, "agent");
            asm volatile("s_waitcnt vmcnt(0)" ::: "memory");
            const unsigned og = xb_add(&bar[XB_TOP], 1u);
            const unsigned tg = og / nx;
            if (og + 1u == (tg + 1u) * nx) xb_add(&bar[XB_TOPGEN], 1u);
            else XB_SPIN(xb_ld(&bar[XB_TOPGEN]) == tg, bar);
            __builtin_amdgcn_fence(__ATOMIC_ACQUIRE, "agent");
            xb_add(&bar[XB_XGEN(b.x)], 1u);
            asm volatile("s_waitcnt vmcnt(0)" ::: "memory");
        } else {
            XB_SPIN(xb_ld(&bar[XB_XGEN(b.x)]) == gen, bar);
            __builtin_amdgcn_fence(__ATOMIC_ACQUIRE, "agent");
            asm volatile("s_waitcnt vmcnt(0)" ::: "memory");
        }
    }
    __syncthreads();
}


using pg8::bf16_t; using pg8::bf16x8; using pg8::f32x4; using pg8::u32x4;
typedef unsigned u32x2 __attribute__((ext_vector_type(2)));

constexpr int T = 16384, DM = 1024, FF = 2816, SEQ = 4096;
constexpr float EPS = 1e-6f;
constexpr float QSCALE = 0.08838834764831845f;

constexpr size_t SZ_GU = (size_t)5632 * 1024 * 2, SZ_DN = (size_t)1024 * 2816 * 2;
constexpr size_t WS_CTL = 0;
constexpr size_t WS_BAR = 4096;
constexpr size_t CTL_BYTES = 32768;
constexpr size_t WS_GU1 = CTL_BYTES;
constexpr size_t WS_DN1 = WS_GU1 + SZ_GU;
constexpr size_t WS_GU2 = WS_DN1 + SZ_DN;
constexpr size_t WS_DN2 = WS_GU2 + SZ_GU;
constexpr size_t WS_WIN = WS_DN2 + SZ_DN;
constexpr size_t WS_WOUT = WS_WIN + (size_t)4096 * 1024 * 2;
constexpr size_t WS_XN = WS_WOUT + (size_t)1024 * 1024 * 2;
constexpr size_t WS_BIG = WS_XN + (size_t)T * 1024 * 2;
constexpr size_t WS_VT = WS_BIG + (size_t)T * 3584 * 2;
constexpr size_t WS_OB = WS_VT + (size_t)1024 * T * 2;
constexpr size_t WS_SM = WS_OB + (size_t)T * 1024 * 2;
constexpr size_t WS_CF = WS_SM + (size_t)T * 16 * 4;
constexpr size_t WS_GL = WS_CF + (size_t)16 * 4096 * 4;
constexpr size_t WS_DNX = WS_GL + 4096;
constexpr size_t DNX_UNIT = 73728;
constexpr size_t WS_OF = WS_DNX + 1024 * DNX_UNIT;
constexpr size_t WS_PSD = WS_OF + (size_t)T * 512 * 4;
constexpr size_t WS_PS = WS_PSD + (size_t)T * 16 * 4;
constexpr size_t WS_END = WS_PS + (size_t)T * 16 * 4;
constexpr int LDS_BYTES = 152 * 1024;
constexpr int RS_TAB_OFF = 128 * 1024;

__device__ __forceinline__ float bf2f(unsigned short b) { return __uint_as_float(((unsigned)b) << 16); }
__device__ __forceinline__ float bflo(unsigned w) { return __uint_as_float(w << 16); }
__device__ __forceinline__ float bfhi(unsigned w) { return __uint_as_float(w & 0xffff0000u); }
typedef __bf16 bf16v2_t __attribute__((ext_vector_type(2)));
typedef float f32v2_t __attribute__((ext_vector_type(2)));
__device__ __forceinline__ unsigned pk2(float lo, float hi) { const f32v2_t f = {lo, hi}; const bf16v2_t v = __builtin_convertvector(f, bf16v2_t); return __builtin_bit_cast(unsigned, v); }
__device__ __forceinline__ float fast_rcp(float x) { return __builtin_amdgcn_rcpf(x); }
__device__ __forceinline__ float sigmoid_(float x) { return fast_rcp(1.f + __expf(-x)); }
__device__ __forceinline__ float silu_(float x) { return x * sigmoid_(x); }
__device__ __forceinline__ float softplus_(float x) { return fmaxf(x, 0.f) + __logf(1.f + __expf(-fabsf(x))); }
__device__ __forceinline__ float wave_sum(float v) {
#pragma unroll
  for (int o = 32; o; o >>= 1) v += __shfl_xor(v, o);
  return v;
}

struct Args { const float* in[19]; float* out; unsigned char* ws; };
typedef const __attribute__((address_space(4))) Args* ArgsP;
__device__ __forceinline__ ArgsP fresh_args() { auto p = __builtin_amdgcn_kernarg_segment_ptr(); asm volatile("" : "+s"(p)); return (ArgsP)p; }

__device__ __forceinline__ float rstd_of(const float* PS, int row) {
  const float4 a = *(const float4*)(PS + (size_t)row * 16), b = *(const float4*)(PS + (size_t)row * 16 + 4), c = *(const float4*)(PS + (size_t)row * 16 + 8), d = *(const float4*)(PS + (size_t)row * 16 + 12);
  const float s = ((a.x + a.y) + (a.z + a.w)) + ((b.x + b.y) + (b.z + b.w)) + ((c.x + c.y) + (c.z + c.w)) + ((d.x + d.y) + (d.z + d.w));
  return rsqrtf(s * (1.f / 1024.f) + EPS);
}
struct EpiAny {
  static constexpr bool AFTER_DRAIN = false;
  int mode; void* P; int ldc; float scale;
  __device__ __forceinline__ bool perm() const { return mode != 1; }
  template <class Sched> __device__ __forceinline__ void prepare(const Sched& S, int tid) const {
    if (mode == 1) return;
    extern __shared__ __attribute__((aligned(16))) unsigned char lds_ep[];
    const float* PSg = (const float*)(fresh_args()->ws + WS_PS); float* tab = (float*)(lds_ep + RS_TAB_OFF);
    const int th = __builtin_amdgcn_readfirstlane(tid >> 8), tr = tid & 255;
    float4 pv[3][4]; bool ok[3];
#pragma unroll
    for (int ps = 0; ps < 3; ++ps) {
      pg8::Unit uu; ok[ps] = S.next(ps * 2 + th, uu);
      const float* pp = PSg + (size_t)((mode == 3 ? uu.pn : uu.pm) * 256 + tr) * 16;
#pragma unroll
      for (int k = 0; k < 4; ++k) pv[ps][k] = ok[ps] ? *(const float4*)(pp + 4 * k) : make_float4(0.f, 0.f, 0.f, 0.f);
    }
#pragma unroll
    for (int ps = 0; ps < 3; ++ps) {
      float s = 0.f;
#pragma unroll
      for (int k = 0; k < 4; ++k) s += (pv[ps][k].x + pv[ps][k].y) + (pv[ps][k].z + pv[ps][k].w);
      if (ok[ps]) tab[(ps * 2 + th) * 256 + tr] = rsqrtf(s * (1.f / 1024.f) + EPS);
    }
  }
  __device__ __forceinline__ void init(f32x4 (&acc)[2][2][4][2], const pg8::Unit& u, int wr, int wc, int fr, int fq) const {
    if (mode == 1) {
      const float* X = (const float*)P; const float inv = 1.f / scale;
      const int row0 = u.pm * 256 + wr * 64 + fr, col0 = u.pn * 256 + wc * 32 + 4 * fq;
#pragma unroll
      for (int ai = 0; ai < 2; ++ai)
#pragma unroll
        for (int m = 0; m < 4; ++m)
#pragma unroll
          for (int bj = 0; bj < 2; ++bj)
#pragma unroll
            for (int n = 0; n < 2; ++n) acc[ai][bj][m][n] = *(const f32x4*)(X + (size_t)(row0 + ai * 128 + m * 16) * ldc + col0 + bj * 128 + n * 16) * inv;
    } else {
#pragma unroll
      for (int ai = 0; ai < 2; ++ai)
#pragma unroll
        for (int m = 0; m < 4; ++m)
#pragma unroll
          for (int bj = 0; bj < 2; ++bj)
#pragma unroll
            for (int n = 0; n < 2; ++n) acc[ai][bj][m][n] = (f32x4){0.f, 0.f, 0.f, 0.f};
    }
  }
  __device__ __forceinline__ void operator()(const f32x4 (&acc)[2][2][4][2], const pg8::Unit& u, int wr, int wc, int fr, int fq, int ui) const {
    extern __shared__ __attribute__((aligned(16))) unsigned char lds_ep[];
    const float* tab = (const float*)(lds_ep + RS_TAB_OFF) + ui * 256;
    unsigned char* ws_ = fresh_args()->ws; float* PS = (float*)(ws_ + WS_PS); bf16_t* XB = (bf16_t*)(ws_ + WS_XN);
    if (mode == 0) {
      bf16_t* O = (bf16_t*)P;
      const int row0 = u.pm * 256 + wr * 64 + fr, col0 = u.pn * 128 + wc * 32 + 8 * fq;
#pragma unroll
      for (int ai = 0; ai < 2; ++ai)
#pragma unroll
        for (int m = 0; m < 4; ++m) {
          const int row = row0 + ai * 128 + m * 16;
          const float rs = tab[wr * 64 + fr + ai * 128 + m * 16];
          bf16_t* rowp = O + (size_t)row * ldc + col0;
          unsigned wv[4];
#pragma unroll
          for (int n = 0; n < 2; ++n)
#pragma unroll
            for (int jp = 0; jp < 2; ++jp) {
              const f32v2_t g = (f32v2_t){acc[ai][0][m][n][2 * jp], acc[ai][0][m][n][2 * jp + 1]} * rs;
              const f32v2_t up = (f32v2_t){acc[ai][1][m][n][2 * jp], acc[ai][1][m][n][2 * jp + 1]} * rs;
              const f32v2_t t = g * (-1.44269504089f);
              f32v2_t e; e.x = __builtin_amdgcn_exp2f(t.x); e.y = __builtin_amdgcn_exp2f(t.y);
              const f32v2_t d = e + 1.0f;
              f32v2_t q; q.x = __builtin_amdgcn_rcpf(d.x); q.y = __builtin_amdgcn_rcpf(d.y);
              const f32v2_t o = (g * up) * q;
              wv[n * 2 + jp] = pk2(o.x, o.y);
            }
          u32x4 w; w.x = wv[0]; w.y = wv[1]; w.z = wv[2]; w.w = wv[3];
          *(u32x4*)rowp = w;
        }
    } else if (mode == 1) {
      float* X = (float*)P;
      const int row0 = u.pm * 256 + wr * 64 + fr, col0 = u.pn * 256 + wc * 32 + 4 * fq;
#pragma unroll
      for (int ai = 0; ai < 2; ++ai)
#pragma unroll
        for (int m = 0; m < 4; ++m) {
          const int row = row0 + ai * 128 + m * 16;
          float* rowp = X + (size_t)row * ldc + col0; bf16_t* rowb = XB + (size_t)row * ldc + col0;
          float ss = 0.f;
#pragma unroll
          for (int bj = 0; bj < 2; ++bj)
#pragma unroll
            for (int n = 0; n < 2; ++n) {
              const f32x4 v = acc[ai][bj][m][n] * scale;
              *(f32x4*)(rowp + bj * 128 + n * 16) = v;
              u32x2 w; w.x = pk2(v[0], v[1]); w.y = pk2(v[2], v[3]); *(u32x2*)(rowb + bj * 128 + n * 16) = w;
              ss += (v[0] * v[0] + v[1] * v[1]) + (v[2] * v[2] + v[3] * v[3]);
            }
          ss += __shfl_xor(ss, 16); ss += __shfl_xor(ss, 32);
          if (fq == 0) PS[(size_t)row * 16 + u.pn * 4 + wc] = ss;
        }
    } else if (mode == 2) {
      bf16_t* O = (bf16_t*)P;
      const int row0 = u.pm * 256 + wr * 64 + fr, col0 = u.pn * 256 + wc * 32 + 8 * fq;
#pragma unroll
      for (int ai = 0; ai < 2; ++ai)
#pragma unroll
        for (int m = 0; m < 4; ++m) {
          const int row = row0 + ai * 128 + m * 16;
          const float rs = tab[wr * 64 + fr + ai * 128 + m * 16];
          bf16_t* rowp = O + (size_t)row * ldc + col0;
#pragma unroll
          for (int bj = 0; bj < 2; ++bj) {
            const f32x4 v0 = acc[ai][bj][m][0] * rs, v1 = acc[ai][bj][m][1] * rs;
            u32x4 w; w.x = pk2(v0[0], v0[1]); w.y = pk2(v0[2], v0[3]); w.z = pk2(v1[0], v1[1]); w.w = pk2(v1[2], v1[3]);
            *(u32x4*)(rowp + bj * 128) = w;
          }
        }
    } else {
      bf16_t* O = (bf16_t*)P;
      const int row0 = u.pm * 256 + wr * 64 + fr, col0 = u.pn * 256 + wc * 32 + 8 * fq;
#pragma unroll
      for (int bj = 0; bj < 2; ++bj) {
        float rc[8];
#pragma unroll
        for (int e = 0; e < 8; ++e) rc[e] = tab[wc * 32 + 8 * fq + bj * 128 + e];
#pragma unroll
        for (int ai = 0; ai < 2; ++ai)
#pragma unroll
          for (int m = 0; m < 4; ++m) {
            bf16_t* rowp = O + (size_t)(row0 + ai * 128 + m * 16) * ldc + col0 + bj * 128;
            const f32x4 v0 = acc[ai][bj][m][0], v1 = acc[ai][bj][m][1];
            u32x4 w; w.x = pk2(v0[0] * rc[0], v0[1] * rc[1]); w.y = pk2(v0[2] * rc[2], v0[3] * rc[3]); w.z = pk2(v1[0] * rc[4], v1[1] * rc[5]); w.w = pk2(v1[2] * rc[6], v1[3] * rc[7]);
            *(u32x4*)rowp = w;
          }
      }
    }
  }
};

__device__ __forceinline__ void transpose_job(float* sT, const float* src, int ld, int K, int ncols, bf16_t* dst, int rs, int roff, int& rot, const float* gain) {
  const int tid = tid_fresh(), G = gridDim.x;
  const int ntn = ncols >> 6, ntiles = (K >> 6) * ntn;
  int first = (int)blockIdx.x - rot; if (first < 0) first += G;
  for (int t = first; t < ntiles; t += G) {
    const int kt = t / ntn, nt = t - kt * ntn; const int k0 = kt * 64, n0 = nt * 64;
    { const int r = tid >> 4, c4 = (tid & 15) * 4;
#pragma unroll
      for (int i = 0; i < 2; ++i) { const float4 v = *(const float4*)(src + (size_t)(k0 + r + 32 * i) * ld + n0 + c4); float* p = sT + (r + 32 * i) * 65 + c4; p[0] = v.x; p[1] = v.y; p[2] = v.z; p[3] = v.w; } }
    __syncthreads();
    { const int n = tid >> 3, ks = (tid & 7) * 8; const float* p = sT + ks * 65 + n;
      float4 ga = make_float4(1.f, 1.f, 1.f, 1.f), gb = ga;
      if (gain) { ga = *(const float4*)(gain + k0 + ks); gb = *(const float4*)(gain + k0 + ks + 4); }
      u32x4 w; w.x = pk2(p[0] * ga.x, p[65] * ga.y); w.y = pk2(p[130] * ga.z, p[195] * ga.w); w.z = pk2(p[260] * gb.x, p[325] * gb.y); w.w = pk2(p[390] * gb.z, p[455] * gb.w);
      const int na = n0 + n; const int row = roff + (na >> 7) * rs + (na & 127);
      *(u32x4*)(dst + (size_t)row * K + k0 + ks) = w; }
    __syncthreads();
  }
  rot = (rot + ntiles) % G;
}

struct ConvJob { const float* src; int ld, K, ntn; bf16_t* dst; int rs, roff; const float* gain; int kt, nt; };
__device__ __forceinline__ ConvJob conv_decode(int t, bool even, int l, int j, ArgsP a, unsigned char* ws) {
  ConvJob J; int base = 0, n;
  const float* gu1 = a->in[2] + (size_t)l * 1024 * 5632; const float* gu2 = a->in[17] + (size_t)l * 1024 * 5632;
#define CJ(cnt, S_, LD_, K_, NC_, D_, RS_, RO_, G_) n = (cnt); if (t < base + n) { J.src = (S_); J.ld = (LD_); J.K = (K_); J.ntn = (NC_) >> 6; J.dst = (D_); J.rs = (RS_); J.roff = (RO_); J.gain = (G_); const int tt = t - base; J.kt = tt / J.ntn; J.nt = tt - J.kt * J.ntn; return J; } base += n;
  CJ(704, gu1, 5632, 1024, 2816, (bf16_t*)(ws + WS_GU1), 256, 0, a->in[1] + l * 1024)
  CJ(704, gu1 + 2816, 5632, 1024, 2816, (bf16_t*)(ws + WS_GU1), 256, 128, a->in[1] + l * 1024)
  CJ(704, a->in[3] + (size_t)l * 2816 * 1024, 1024, 2816, 1024, (bf16_t*)(ws + WS_DN1), 128, 0, nullptr)
  CJ(704, gu2, 5632, 1024, 2816, (bf16_t*)(ws + WS_GU2), 256, 0, a->in[16] + l * 1024)
  CJ(704, gu2 + 2816, 5632, 1024, 2816, (bf16_t*)(ws + WS_GU2), 256, 128, a->in[16] + l * 1024)
  CJ(704, a->in[18] + (size_t)l * 2816 * 1024, 1024, 2816, 1024, (bf16_t*)(ws + WS_DN2), 128, 0, nullptr)
  const float* gm = a->in[4] + l * 1024;
  if (even) {
    const float* wi = a->in[5] + (size_t)j * 1024 * 4108;
    CJ(512, wi, 4108, 1024, 2048, (bf16_t*)(ws + WS_WIN), 128, 0, gm)
    CJ(256, wi + 2056, 4108, 1024, 1024, (bf16_t*)(ws + WS_WIN), 128, 2048, gm)
    CJ(128, wi + 3592, 4108, 1024, 512, (bf16_t*)(ws + WS_WIN), 128, 3072, gm)
    CJ(128, wi + 3080, 4108, 1024, 512, (bf16_t*)(ws + WS_WIN), 128, 3584, gm)
    CJ(256, a->in[13] + (size_t)j * 1024 * 1024, 1024, 1024, 1024, (bf16_t*)(ws + WS_WOUT), 128, 0, nullptr)
  } else {
    CJ(768, a->in[14] + (size_t)j * 1024 * 3072, 3072, 1024, 3072, (bf16_t*)(ws + WS_WIN), 128, 0, gm)
    CJ(256, a->in[15] + (size_t)j * 1024 * 1024, 1024, 1024, 1024, (bf16_t*)(ws + WS_WOUT), 128, 0, nullptr)
  }
#undef CJ
  J.src = nullptr; J.ld = 0; J.K = 0; J.ntn = 1; J.dst = nullptr; J.rs = 0; J.roff = 0; J.gain = nullptr; J.kt = 0; J.nt = 0;
  return J;
}
__device__ __forceinline__ void convert_layer(float* sT, bool even, int l, int j, ArgsP a, unsigned char* ws) {
  const int tid = tid_fresh(), G = gridDim.x;
  const int total = 6 * 704 + (even ? 1280 : 1024);
  const int r = tid >> 4, c4 = (tid & 15) * 4;
  int t = blockIdx.x; asm volatile("" : "+s"(t));
  if (t >= total) return;
  float4 v0, v1;
  { const ConvJob J = conv_decode(t, even, l, j, a, ws);
    v0 = *(const float4*)(J.src + (size_t)(J.kt * 64 + r) * J.ld + J.nt * 64 + c4); v1 = *(const float4*)(J.src + (size_t)(J.kt * 64 + r + 32) * J.ld + J.nt * 64 + c4); }
  for (;;) {
    const int tn = t + G; const bool more = tn < total;
    float4 n0 = v0, n1 = v1;
    if (more) { const ConvJob Jn = conv_decode(tn, even, l, j, a, ws);
      n0 = *(const float4*)(Jn.src + (size_t)(Jn.kt * 64 + r) * Jn.ld + Jn.nt * 64 + c4); n1 = *(const float4*)(Jn.src + (size_t)(Jn.kt * 64 + r + 32) * Jn.ld + Jn.nt * 64 + c4); }
    { float* p = sT + r * 65 + c4; p[0] = v0.x; p[1] = v0.y; p[2] = v0.z; p[3] = v0.w; float* q = sT + (r + 32) * 65 + c4; q[0] = v1.x; q[1] = v1.y; q[2] = v1.z; q[3] = v1.w; }
    __syncthreads();
    { const ConvJob J = conv_decode(t, even, l, j, a, ws);
      const int k0 = J.kt * 64, n = tid >> 3, ks = (tid & 7) * 8; const float* p = sT + ks * 65 + n;
      float4 ga = make_float4(1.f, 1.f, 1.f, 1.f), gb = ga;
      if (J.gain) { ga = *(const float4*)(J.gain + k0 + ks); gb = *(const float4*)(J.gain + k0 + ks + 4); }
      u32x4 w; w.x = pk2(p[0] * ga.x, p[65] * ga.y); w.y = pk2(p[130] * ga.z, p[195] * ga.w); w.z = pk2(p[260] * gb.x, p[325] * gb.y); w.w = pk2(p[390] * gb.z, p[455] * gb.w);
      const int na = J.nt * 64 + n; const int row = J.roff + (na >> 7) * J.rs + (na & 127);
      *(u32x4*)(J.dst + (size_t)row * J.K + k0 + ks) = w; }
    __syncthreads();
    if (!more) break;
    t = tn; v0 = n0; v1 = n1;
  }
}

template <bool SMALL>
__device__ __forceinline__ void norm_phase(unsigned char* lds, const float* xsrc, float* xcopy, const float* gain, bf16_t* XN,
                                           const float* w_in, const float* a_log, const float* dt_bias, const float* f_bias, float* SM) {
  const int tid = tid_fresh(), lane = tid & 63, wave = tid >> 6;
  float* ws_s = (float*)lds;
  if (SMALL) {
    for (int e = tid; e < 12288; e += 512) { const int k = e / 12, c = e - k * 12; const int col = c < 8 ? 2048 + c : 4096 + c; ws_s[c * 1024 + k] = w_in[(size_t)k * 4108 + col]; }
    __syncthreads();
  }
  float4 gv[4];
#pragma unroll
  for (int j = 0; j < 4; ++j) gv[j] = *(const float4*)(gain + lane * 4 + 256 * j);
  float4 xnx[4];
  { const int row0 = blockIdx.x * 8 + wave;
#pragma unroll
    for (int j = 0; j < 4; ++j) xnx[j] = *(const float4*)(xsrc + (size_t)(row0 < T ? row0 : 0) * 1024 + lane * 4 + 256 * j); }
  for (int row = blockIdx.x * 8 + wave; row < T; row += gridDim.x * 8) {
    float4 xv[4]; float ss = 0.f;
#pragma unroll
    for (int j = 0; j < 4; ++j) xv[j] = xnx[j];
    { const int rn = row + gridDim.x * 8;
      if (rn < T) {
#pragma unroll
        for (int j = 0; j < 4; ++j) xnx[j] = *(const float4*)(xsrc + (size_t)rn * 1024 + lane * 4 + 256 * j);
      } }
#pragma unroll
    for (int j = 0; j < 4; ++j) ss += xv[j].x * xv[j].x + xv[j].y * xv[j].y + xv[j].z * xv[j].z + xv[j].w * xv[j].w;
    if (xcopy) {
#pragma unroll
      for (int j = 0; j < 4; ++j) *(float4*)(xcopy + (size_t)row * 1024 + lane * 4 + 256 * j) = xv[j];
    }
    ss = wave_sum(ss);
    const float rstd = rsqrtf(ss * (1.f / 1024.f) + EPS);
#pragma unroll
    for (int j = 0; j < 4; ++j) {
      xv[j].x = xv[j].x * rstd * gv[j].x; xv[j].y = xv[j].y * rstd * gv[j].y; xv[j].z = xv[j].z * rstd * gv[j].z; xv[j].w = xv[j].w * rstd * gv[j].w;
      if (XN) { u32x2 w; w.x = pk2(xv[j].x, xv[j].y); w.y = pk2(xv[j].z, xv[j].w); *(u32x2*)(XN + (size_t)row * 1024 + lane * 4 + 256 * j) = w; }
    }
    if (SMALL) {
      float* red = (float*)(lds + 49152) + wave * (12 * 68);
#pragma unroll
      for (int c = 0; c < 12; ++c) {
        float d = 0.f;
#pragma unroll
        for (int j = 0; j < 4; ++j) { const float4 wv = *(const float4*)(ws_s + c * 1024 + lane * 4 + 256 * j); d += xv[j].x * wv.x + xv[j].y * wv.y + xv[j].z * wv.z + xv[j].w * wv.w; }
        red[c * 68 + lane] = d;
      }
      float mine = 0.f;
      if (lane < 12) {
        float s0 = 0.f, s1 = 0.f, s2 = 0.f, s3 = 0.f;
#pragma unroll
        for (int i4 = 0; i4 < 16; ++i4) { const float4 v = *(const float4*)(red + lane * 68 + 4 * i4); s0 += v.x; s1 += v.y; s2 += v.z; s3 += v.w; }
        mine = (s0 + s1) + (s2 + s3);
      }
      if (lane < 12) {
        const int h = lane & 3; float o;
        if (lane < 4) o = sigmoid_(mine);
        else if (lane < 8) o = -__expf(a_log[h]) * softplus_(mine + dt_bias[h]);
        else o = -softplus_(-(mine + f_bias[h]));
        SM[(size_t)row * 16 + lane] = o;
      }
    }
  }
  if (SMALL) __syncthreads();
}


__device__ __forceinline__ void init_phase(const float* xin, float* X, bf16_t* XB, float* PS) {
  const int tid = tid_fresh(), lane = tid & 63, wave = tid >> 6;
  for (int row = blockIdx.x * 8 + wave; row < T; row += gridDim.x * 8) {
    float ss = 0.f;
#pragma unroll
    for (int j = 0; j < 4; ++j) {
      const float4 v = *(const float4*)(xin + (size_t)row * 1024 + lane * 4 + 256 * j);
      *(float4*)(X + (size_t)row * 1024 + lane * 4 + 256 * j) = v;
      u32x2 w; w.x = pk2(v.x, v.y); w.y = pk2(v.z, v.w); *(u32x2*)(XB + (size_t)row * 1024 + lane * 4 + 256 * j) = w;
      ss += (v.x * v.x + v.y * v.y) + (v.z * v.z + v.w * v.w);
    }
    ss = wave_sum(ss);
    if (lane < 16) PS[(size_t)row * 16 + lane] = (lane == 0) ? ss : 0.f;
  }
}

__device__ __forceinline__ void cumsum_logf(unsigned char* lds, const float* SM, float* CF) {
  if (blockIdx.x < 16) {
    const int tid = tid_fresh(), lane = tid & 63, wave = tid >> 6;
    const int seq = blockIdx.x, b = seq >> 2, h = seq & 3; float* red = (float*)lds;
    float v[8]; float run = 0.f;
#pragma unroll
    for (int e = 0; e < 8; ++e) { run += SM[((size_t)(b * 4096 + tid * 8 + e)) * 16 + 8 + h]; v[e] = run; }
    float sc = run;
#pragma unroll
    for (int o = 1; o < 64; o <<= 1) { const float t = __shfl_up(sc, o); if (lane >= o) sc += t; }
    if (lane == 63) red[wave] = sc;
    __syncthreads();
    float base = sc - run;
    for (int w2 = 0; w2 < wave; ++w2) base += red[w2];
#pragma unroll
    for (int e = 0; e < 8; ++e) CF[seq * 4096 + tid * 8 + e] = v[e] + base;
    __syncthreads();
  }
}

#define MFMA16(a, b, c) __builtin_amdgcn_mfma_f32_16x16x32_bf16((a), (b), (c), 0, 0, 0)

__device__ __forceinline__ void dn_prep_unit(unsigned char* lds, int u, const bf16_t* BIG, const float* SM, const float* convw, unsigned char* DNX, float* GL) {
  const int tid = tid_fresh(), lane = tid & 63, wave = tid >> 6;
  bf16_t* q_s = (bf16_t*)lds; bf16_t* k_s = (bf16_t*)(lds + 17408); float* A_s = (float*)(lds + 34816);
  float* gc_s = (float*)(lds + 52224); float* beta_s = (float*)(lds + 52480); float* rhs = (float*)(lds + 52736); float* cw_s = (float*)(lds + 118272);
  const int bh = u >> 6, n = u & 63, b = bh >> 2, h = bh & 3; const int t0 = b * SEQ + n * 64;
  unsigned char* ux = DNX + (size_t)u * DNX_UNIT;
  bf16_t* UT = (bf16_t*)ux; bf16_t* Wd = (bf16_t*)(ux + 16384); bf16_t* QD = (bf16_t*)(ux + 32768); bf16_t* KDT = (bf16_t*)(ux + 49152); bf16_t* AT = (bf16_t*)(ux + 65536);
  const int s = tid >> 3, c0 = (tid & 7) * 16;
  u32x4 xr[3][4][2];
#pragma unroll
  for (int sel = 0; sel < 3; ++sel)
#pragma unroll
    for (int i = 0; i < 4; ++i) {
      const int sr = n * 64 + s - 3 + i; const int srl = sr < 0 ? 0 : sr;
      const bf16_t* xp = BIG + (size_t)(b * SEQ + srl) * 3584 + sel * 512 + h * 128 + c0;
      xr[sel][i][0] = *(const u32x4*)xp; xr[sel][i][1] = *(const u32x4*)(xp + 8);
    }
  if (tid < 64) {
    float g = SM[(size_t)(t0 + tid) * 16 + 4 + h];
#pragma unroll
    for (int o = 1; o < 64; o <<= 1) { const float t = __shfl_up(g, o); if (lane >= o) g += t; }
    gc_s[tid] = g; beta_s[tid] = SM[(size_t)(t0 + tid) * 16 + h];
    if (tid == 63) GL[u] = __expf(g);
  }
  for (int e = tid; e < 1536; e += 512) { const int i = e / 384, r = e - i * 384, sel = r >> 7, c = r & 127; cw_s[e] = convw[i * 1536 + sel * 512 + h * 128 + c]; }
  __syncthreads();
#ifndef NREP_CV
#define NREP_CV 1
#endif
  for (int rep_cv = 0; rep_cv < NREP_CV; ++rep_cv)
  {
    const float bs = beta_s[s], eg = __expf(gc_s[s]);
#pragma unroll
    for (int sel = 0; sel < 3; ++sel) {
      float a[16];
#pragma unroll
      for (int e = 0; e < 16; ++e) a[e] = 0.f;
#pragma unroll
      for (int i = 0; i < 4; ++i) {
        const int sr = n * 64 + s - 3 + i; const float mk = sr < 0 ? 0.f : 1.f;
        const u32x4 x0 = xr[sel][i][0], x1 = xr[sel][i][1];
        const float* wp = cw_s + i * 384 + sel * 128 + c0;
        float4 w0 = *(const float4*)wp, w1 = *(const float4*)(wp + 4), w2 = *(const float4*)(wp + 8), w3 = *(const float4*)(wp + 12);
        w0.x *= mk; w0.y *= mk; w0.z *= mk; w0.w *= mk; w1.x *= mk; w1.y *= mk; w1.z *= mk; w1.w *= mk;
        w2.x *= mk; w2.y *= mk; w2.z *= mk; w2.w *= mk; w3.x *= mk; w3.y *= mk; w3.z *= mk; w3.w *= mk;
        a[0] += bflo(x0.x) * w0.x; a[1] += bfhi(x0.x) * w0.y; a[2] += bflo(x0.y) * w0.z; a[3] += bfhi(x0.y) * w0.w;
        a[4] += bflo(x0.z) * w1.x; a[5] += bfhi(x0.z) * w1.y; a[6] += bflo(x0.w) * w1.z; a[7] += bfhi(x0.w) * w1.w;
        a[8] += bflo(x1.x) * w2.x; a[9] += bfhi(x1.x) * w2.y; a[10] += bflo(x1.y) * w2.z; a[11] += bfhi(x1.y) * w2.w;
        a[12] += bflo(x1.z) * w3.x; a[13] += bfhi(x1.z) * w3.y; a[14] += bflo(x1.w) * w3.z; a[15] += bfhi(x1.w) * w3.w;
      }
      float ss = 0.f;
#pragma unroll
      for (int e = 0; e < 16; ++e) { a[e] = silu_(a[e]); ss += a[e] * a[e]; }
      if (sel < 2) {
        ss += __shfl_xor(ss, 1); ss += __shfl_xor(ss, 2); ss += __shfl_xor(ss, 4);
        const float r = rsqrtf(ss + EPS) * (sel == 0 ? QSCALE : 1.f);
#pragma unroll
        for (int e = 0; e < 16; ++e) a[e] *= r;
        bf16_t* dsts = (sel == 0 ? q_s : k_s) + s * 136 + c0;
        u32x4 p0, p1;
        p0.x = pk2(a[0], a[1]); p0.y = pk2(a[2], a[3]); p0.z = pk2(a[4], a[5]); p0.w = pk2(a[6], a[7]);
        p1.x = pk2(a[8], a[9]); p1.y = pk2(a[10], a[11]); p1.z = pk2(a[12], a[13]); p1.w = pk2(a[14], a[15]);
        *(u32x4*)dsts = p0; *(u32x4*)(dsts + 8) = p1;
        if (sel == 0) {
          u32x4 d0, d1;
          d0.x = pk2(a[0] * eg, a[1] * eg); d0.y = pk2(a[2] * eg, a[3] * eg); d0.z = pk2(a[4] * eg, a[5] * eg); d0.w = pk2(a[6] * eg, a[7] * eg);
          d1.x = pk2(a[8] * eg, a[9] * eg); d1.y = pk2(a[10] * eg, a[11] * eg); d1.z = pk2(a[12] * eg, a[13] * eg); d1.w = pk2(a[14] * eg, a[15] * eg);
          *(u32x4*)(QD + s * 128 + c0) = d0; *(u32x4*)(QD + s * 128 + c0 + 8) = d1;
        } else {
          const float f = bs * eg; float* rp = rhs + s * 256 + 128 + c0;
#pragma unroll
          for (int e4 = 0; e4 < 4; ++e4) *(float4*)(rp + 4 * e4) = make_float4(a[4 * e4] * f, a[4 * e4 + 1] * f, a[4 * e4 + 2] * f, a[4 * e4 + 3] * f);
        }
      } else {
        float* rp = rhs + s * 256 + c0;
#pragma unroll
        for (int e4 = 0; e4 < 4; ++e4) *(float4*)(rp + 4 * e4) = make_float4(a[4 * e4] * bs, a[4 * e4 + 1] * bs, a[4 * e4 + 2] * bs, a[4 * e4 + 3] * bs);
      }
    }
  }
  __syncthreads();
#ifndef NREP_MM
#define NREP_MM 1
#endif
  for (int rep_mm = 0; rep_mm < NREP_MM; ++rep_mm)
  {
    const int it = wave & 3, sel = wave >> 2, fr = lane & 15, fq = lane >> 4;
    const bf16_t* As = (sel ? q_s : k_s) + (it * 16 + fr) * 136 + fq * 8;
    bf16x8 af[4];
#pragma unroll
    for (int kk = 0; kk < 4; ++kk) af[kk] = *(const bf16x8*)(As + 32 * kk);
#pragma unroll
    for (int jt = 0; jt < 4; ++jt) {
      f32x4 acc = {0.f, 0.f, 0.f, 0.f};
      if (jt <= it) {
        const bf16_t* Bs = k_s + (jt * 16 + fr) * 136 + fq * 8;
#pragma unroll
        for (int kk = 0; kk < 4; ++kk) acc = MFMA16(af[kk], *(const bf16x8*)(Bs + 32 * kk), acc);
      }
      const int jj = jt * 16 + fr; const float gj = gc_s[jj];
#pragma unroll
      for (int j = 0; j < 4; ++j) {
        const int i = it * 16 + fq * 4 + j;
        const float dec = __expf(fminf(gc_s[i] - gj, 0.f));
        if (sel == 0) A_s[i * 68 + jj] = (i > jj) ? beta_s[i] * acc[j] * dec : 0.f;
        else { const float v = (i >= jj) ? acc[j] * dec : 0.f; AT[i * 64 + jj] = (bf16_t)(pk2(v, 0.f) & 0xffffu); }
      }
    }
  }
  {
    const int d = tid >> 2, sg = (tid & 3) * 16; const float gl = gc_s[63];
    float v[16];
#pragma unroll
    for (int e = 0; e < 16; ++e) v[e] = bf2f(k_s[(sg + e) * 136 + d]) * __expf(gl - gc_s[sg + e]);
    u32x4 p0, p1;
    p0.x = pk2(v[0], v[1]); p0.y = pk2(v[2], v[3]); p0.z = pk2(v[4], v[5]); p0.w = pk2(v[6], v[7]);
    p1.x = pk2(v[8], v[9]); p1.y = pk2(v[10], v[11]); p1.z = pk2(v[12], v[13]); p1.w = pk2(v[14], v[15]);
    *(u32x4*)(KDT + d * 64 + sg) = p0; *(u32x4*)(KDT + d * 64 + sg + 8) = p1;
  }
  __syncthreads();
#ifndef NREP_FS
#define NREP_FS 1
#endif
  float* Ti_s = (float*)(lds + 124416);
  if (wave < 4 && lane < 16) {
    const int I = wave; const float* Ab = A_s + (I * 16) * 68 + I * 16;
    float t[16];
#pragma unroll
    for (int r = 0; r < 16; ++r) {
      float v = (r == lane) ? 1.f : 0.f;
#pragma unroll
      for (int j = 0; j < r; ++j) v -= Ab[r * 68 + j] * t[j];
      t[r] = v;
    }
#pragma unroll
    for (int r = 0; r < 16; ++r) Ti_s[(I * 16 + r) * 20 + lane] = t[r];
  }
  __syncthreads();
  for (int rep_fs = 0; rep_fs < NREP_FS; ++rep_fs)
  {
    const int fr = lane & 15, fq = lane >> 4;
#pragma unroll
    for (int I = 0; I < 4; ++I) {
      f32x4 ac[2];
      ac[0] = (f32x4){0.f, 0.f, 0.f, 0.f}; ac[1] = (f32x4){0.f, 0.f, 0.f, 0.f};
#pragma unroll
      for (int J = 0; J < I; ++J)
#pragma unroll
        for (int kk = 0; kk < 4; ++kk) {
          const float a = A_s[(I * 16 + fr) * 68 + J * 16 + 4 * kk + fq];
#pragma unroll
          for (int c2 = 0; c2 < 2; ++c2) ac[c2] = __builtin_amdgcn_mfma_f32_16x16x4f32(a, rhs[(J * 16 + 4 * kk + fq) * 256 + wave * 32 + c2 * 16 + fr], ac[c2], 0, 0, 0);
        }
#pragma unroll
      for (int c2 = 0; c2 < 2; ++c2)
#pragma unroll
        for (int j = 0; j < 4; ++j) { float* p = rhs + (I * 16 + fq * 4 + j) * 256 + wave * 32 + c2 * 16 + fr; *p = *p - ac[c2][j]; }
      f32x4 xc[2];
      xc[0] = (f32x4){0.f, 0.f, 0.f, 0.f}; xc[1] = (f32x4){0.f, 0.f, 0.f, 0.f};
#pragma unroll
      for (int kk = 0; kk < 4; ++kk) {
        const float a = Ti_s[(I * 16 + fr) * 20 + 4 * kk + fq];
#pragma unroll
        for (int c2 = 0; c2 < 2; ++c2) xc[c2] = __builtin_amdgcn_mfma_f32_16x16x4f32(a, rhs[(I * 16 + 4 * kk + fq) * 256 + wave * 32 + c2 * 16 + fr], xc[c2], 0, 0, 0);
      }
#pragma unroll
      for (int c2 = 0; c2 < 2; ++c2)
#pragma unroll
        for (int j = 0; j < 4; ++j) rhs[(I * 16 + fq * 4 + j) * 256 + wave * 32 + c2 * 16 + fr] = xc[c2][j];
    }
  }
  __syncthreads();
  {
    const int wi = tid >> 3, wseg = (tid & 7) * 16;
    const float* wp = rhs + wi * 256 + 128 + wseg;
    const float4 w0 = *(const float4*)wp, w1 = *(const float4*)(wp + 4), w2 = *(const float4*)(wp + 8), w3 = *(const float4*)(wp + 12);
    u32x4 p0, p1;
    p0.x = pk2(w0.x, w0.y); p0.y = pk2(w0.z, w0.w); p0.z = pk2(w1.x, w1.y); p0.w = pk2(w1.z, w1.w);
    p1.x = pk2(w2.x, w2.y); p1.y = pk2(w2.z, w2.w); p1.z = pk2(w3.x, w3.y); p1.w = pk2(w3.z, w3.w);
    *(u32x4*)(Wd + wi * 128 + wseg) = p0; *(u32x4*)(Wd + wi * 128 + wseg + 8) = p1;
    const int un = tid >> 2, uc = (tid & 3) * 16;
    float uv[16];
#pragma unroll
    for (int e = 0; e < 16; ++e) uv[e] = rhs[(uc + e) * 256 + un];
    u32x4 q0, q1;
    q0.x = pk2(uv[0], uv[1]); q0.y = pk2(uv[2], uv[3]); q0.z = pk2(uv[4], uv[5]); q0.w = pk2(uv[6], uv[7]);
    q1.x = pk2(uv[8], uv[9]); q1.y = pk2(uv[10], uv[11]); q1.z = pk2(uv[12], uv[13]); q1.w = pk2(uv[14], uv[15]);
    *(u32x4*)(UT + un * 64 + uc) = q0; *(u32x4*)(UT + un * 64 + uc + 8) = q1;
  }
  __syncthreads();
}

__device__ __forceinline__ void dn_scan(unsigned char* lds, int sid, const unsigned char* DNX, const float* GL, float* OF, float* PSD) {
  const int tid = tid_fresh(), lane = tid & 63, wave = tid >> 6, fr = lane & 15, fq = lane >> 4;
  bf16_t* w_s = (bf16_t*)lds; bf16_t* qd_s = (bf16_t*)(lds + 17408); bf16_t* kdT_s = (bf16_t*)(lds + 34816); bf16_t* at_s = (bf16_t*)(lds + 53248);
  bf16_t* ST_s = (bf16_t*)(lds + 62464); bf16_t* vT_s = (bf16_t*)(lds + 71168);
  const int bh = sid >> 2, sl = sid & 3, b = bh >> 2, h = bh & 3;
  for (int e = tid; e < 32 * 136 / 2; e += 512) ((unsigned*)ST_s)[e] = 0u;
  f32x4 Sacc[2];
  Sacc[0] = (f32x4){0.f, 0.f, 0.f, 0.f}; Sacc[1] = (f32x4){0.f, 0.f, 0.f, 0.f};
  const int r64 = tid >> 4, c16 = (tid & 15) * 8;
  const int r128 = tid >> 3, c8 = (tid & 7) * 8;
  u32x4 rw[2], rq[2], rk[2], ra; u32x2 ru[2]; float rgl;
  ru[0] = (u32x2){0u, 0u}; ru[1] = (u32x2){0u, 0u};
#define DN_LOAD(nc) do { const unsigned char* ux = DNX + (size_t)((bh << 6) + (nc)) * DNX_UNIT; \
    const bf16_t* UTg = (const bf16_t*)ux; const bf16_t* Wg = (const bf16_t*)(ux + 16384); const bf16_t* QDg = (const bf16_t*)(ux + 32768); \
    const bf16_t* KDTg = (const bf16_t*)(ux + 49152); const bf16_t* ATg = (const bf16_t*)(ux + 65536); \
    _Pragma("unroll") for (int i = 0; i < 2; ++i) { rw[i] = *(const u32x4*)(Wg + (r64 + 32 * i) * 128 + c16); rq[i] = *(const u32x4*)(QDg + (r64 + 32 * i) * 128 + c16); \
      rk[i] = *(const u32x4*)(KDTg + (r128 + 64 * i) * 64 + c8); } \
    ra = *(const u32x4*)(ATg + r128 * 64 + c8); \
    if (wave < 4) { _Pragma("unroll") for (int c2 = 0; c2 < 2; ++c2) ru[c2] = *(const u32x2*)(UTg + (sl * 32 + c2 * 16 + fr) * 64 + wave * 16 + fq * 4); } \
    rgl = GL[(bh << 6) + (nc)]; } while (0)
  DN_LOAD(0);
  for (int nc = 0; nc < 64; ++nc) {
#pragma unroll
    for (int i = 0; i < 2; ++i) { *(u32x4*)(w_s + (r64 + 32 * i) * 136 + c16) = rw[i]; *(u32x4*)(qd_s + (r64 + 32 * i) * 136 + c16) = rq[i]; *(u32x4*)(kdT_s + (r128 + 64 * i) * 72 + c8) = rk[i]; }
    *(u32x4*)(at_s + r128 * 72 + c8) = ra;
    const u32x2 uc0 = ru[0], uc1 = ru[1];
    const float gl = rgl;
    __syncthreads();
    if (nc + 1 < 64) DN_LOAD(nc + 1);
    f32x4 P[2];
    {
      const bf16_t* Ar = (wave < 4 ? w_s : qd_s) + ((wave & 3) * 16 + fr) * 136 + fq * 8;
      bf16x8 af[4];
#pragma unroll
      for (int kk = 0; kk < 4; ++kk) af[kk] = *(const bf16x8*)(Ar + 32 * kk);
#pragma unroll
      for (int c2 = 0; c2 < 2; ++c2) {
        P[c2] = (f32x4){0.f, 0.f, 0.f, 0.f};
#pragma unroll
        for (int kk = 0; kk < 4; ++kk) P[c2] = MFMA16(af[kk], *(const bf16x8*)(ST_s + (c2 * 16 + fr) * 136 + fq * 8 + 32 * kk), P[c2]);
      }
    }
    if (wave < 4) {
      { const float v0 = bflo(uc0.x) - P[0][0], v1 = bfhi(uc0.x) - P[0][1], v2 = bflo(uc0.y) - P[0][2], v3 = bfhi(uc0.y) - P[0][3];
        u32x2 p; p.x = pk2(v0, v1); p.y = pk2(v2, v3); *(u32x2*)(vT_s + (fr) * 72 + wave * 16 + fq * 4) = p; }
      { const float v0 = bflo(uc1.x) - P[1][0], v1 = bfhi(uc1.x) - P[1][1], v2 = bflo(uc1.y) - P[1][2], v3 = bfhi(uc1.y) - P[1][3];
        u32x2 p; p.x = pk2(v0, v1); p.y = pk2(v2, v3); *(u32x2*)(vT_s + (16 + fr) * 72 + wave * 16 + fq * 4) = p; }
    }
    __syncthreads();
    if (wave >= 4) {
      const int ct = wave - 4;
      bf16x8 aa[2];
#pragma unroll
      for (int g = 0; g < 2; ++g) aa[g] = *(const bf16x8*)(at_s + (ct * 16 + fr) * 72 + fq * 8 + 32 * g);
#pragma unroll
      for (int c2 = 0; c2 < 2; ++c2)
#pragma unroll
        for (int g = 0; g < 2; ++g) P[c2] = MFMA16(aa[g], *(const bf16x8*)(vT_s + (c2 * 16 + fr) * 72 + fq * 8 + 32 * g), P[c2]);
      const int t0 = b * SEQ + nc * 64 + ct * 16 + fq * 4;
#pragma unroll
      for (int j = 0; j < 4; ++j) {
        float* op = OF + (size_t)(t0 + j) * 512 + h * 128 + sl * 32 + fr;
        op[0] = P[0][j]; op[16] = P[1][j];
        float ss = P[0][j] * P[0][j] + P[1][j] * P[1][j];
        ss += __shfl_xor(ss, 1); ss += __shfl_xor(ss, 2); ss += __shfl_xor(ss, 4); ss += __shfl_xor(ss, 8);
        if (fr == 0) PSD[(size_t)(t0 + j) * 16 + h * 4 + sl] = ss;
      }
    }
    {
      bf16x8 ak[2];
#pragma unroll
      for (int g = 0; g < 2; ++g) ak[g] = *(const bf16x8*)(kdT_s + (wave * 16 + fr) * 72 + fq * 8 + 32 * g);
#pragma unroll
      for (int n2 = 0; n2 < 2; ++n2) {
        f32x4 a = Sacc[n2] * gl;
#pragma unroll
        for (int g = 0; g < 2; ++g) a = MFMA16(ak[g], *(const bf16x8*)(vT_s + (n2 * 16 + fr) * 72 + fq * 8 + 32 * g), a);
        Sacc[n2] = a;
        u32x2 p; p.x = pk2(a[0], a[1]); p.y = pk2(a[2], a[3]);
        *(u32x2*)(ST_s + (n2 * 16 + fr) * 136 + wave * 16 + fq * 4) = p;
      }
    }
    __syncthreads();
  }
#undef DN_LOAD
}

__device__ __forceinline__ void dn_fixup(const float* OF, const float* PSD, const bf16_t* BIG, const float* ng, bf16_t* OB) {
  const int tid = tid_fresh();
  for (int it = blockIdx.x * 512 + tid; it < T * 32; it += gridDim.x * 512) {
    const int t = it >> 5, h = (it >> 3) & 3, n0 = (it & 7) * 16;
    const float4 ps = *(const float4*)(PSD + (size_t)t * 16 + h * 4);
    const float rstd = rsqrtf((ps.x + ps.y + ps.z + ps.w) * (1.f / 128.f) + EPS);
    const float* op = OF + (size_t)t * 512 + h * 128 + n0;
    const bf16_t* gp = BIG + (size_t)t * 3584 + 1536 + h * 128 + n0;
    const u32x4 g0 = *(const u32x4*)gp, g1 = *(const u32x4*)(gp + 8);
    float gt[16];
    gt[0] = bflo(g0.x); gt[1] = bfhi(g0.x); gt[2] = bflo(g0.y); gt[3] = bfhi(g0.y); gt[4] = bflo(g0.z); gt[5] = bfhi(g0.z); gt[6] = bflo(g0.w); gt[7] = bfhi(g0.w);
    gt[8] = bflo(g1.x); gt[9] = bfhi(g1.x); gt[10] = bflo(g1.y); gt[11] = bfhi(g1.y); gt[12] = bflo(g1.z); gt[13] = bfhi(g1.z); gt[14] = bflo(g1.w); gt[15] = bfhi(g1.w);
    float o[16];
#pragma unroll
    for (int e4 = 0; e4 < 4; ++e4) { const float4 v = *(const float4*)(op + 4 * e4); const float4 gn = *(const float4*)(ng + n0 + 4 * e4);
      o[4 * e4] = v.x * rstd * gn.x * silu_(gt[4 * e4]); o[4 * e4 + 1] = v.y * rstd * gn.y * silu_(gt[4 * e4 + 1]);
      o[4 * e4 + 2] = v.z * rstd * gn.z * silu_(gt[4 * e4 + 2]); o[4 * e4 + 3] = v.w * rstd * gn.w * silu_(gt[4 * e4 + 3]); }
    u32x4 p0, p1;
    p0.x = pk2(o[0], o[1]); p0.y = pk2(o[2], o[3]); p0.z = pk2(o[4], o[5]); p0.w = pk2(o[6], o[7]);
    p1.x = pk2(o[8], o[9]); p1.y = pk2(o[10], o[11]); p1.z = pk2(o[12], o[13]); p1.w = pk2(o[14], o[15]);
    bf16_t* ob = OB + (size_t)t * 1024 + h * 128 + n0;
    *(u32x4*)ob = p0; *(u32x4*)(ob + 8) = p1;
  }
}

struct AttnP {
  const bf16_t* Q; const bf16_t* K; int ld;
  const bf16_t* VT;
  const float* qg; const float* kg; const float* CF; const bf16_t* gate;
  bf16_t* O;
  int H;
};
template <bool SBK>
__device__ __forceinline__ void attn_unit(unsigned char* lds, const AttnP& P, int bh, int qb) {
  const int tid = tid_fresh(), lane = tid & 63, wave = tid >> 6, fr = lane & 15, fq = lane >> 4;
  bf16_t* K_s = (bf16_t*)lds; bf16_t* V_s = (bf16_t*)(lds + 69632); float* ck_s = (float*)(lds + 143360); volatile int* dflag = (volatile int*)(lds + 144384);
  const int b = bh / P.H, h = bh - b * P.H; const int tb = b * SEQ;
  const int q = qb * 128 + wave * 16 + fr;
  const int qmin_w = qb * 128 + wave * 16, qmax_w = qmin_w + 15;
  const int ld = P.ld;
  bf16x8 Ue, Uo, U1;
  {
    u32x4 e, o, one;
    const unsigned ONE = 0x3F80u;
    unsigned t[4];
#pragma unroll
    for (int i = 0; i < 4; ++i) t[i] = (fq * 4 + i > fr) ? ONE : 0u;
    e.x = t[0] | (t[1] << 16); e.y = t[2] | (t[3] << 16); e.z = ONE | (ONE << 16); e.w = ONE | (ONE << 16);
    o.x = 0u; o.y = 0u; o.z = t[0] | (t[1] << 16); o.w = t[2] | (t[3] << 16);
    one.x = one.y = one.z = one.w = ONE | (ONE << 16);
    Ue = __builtin_bit_cast(bf16x8, e); Uo = __builtin_bit_cast(bf16x8, o); U1 = __builtin_bit_cast(bf16x8, one);
  }
  const int nt = 2 * qb + 2;
  f32x4 acc_o[8];
#pragma unroll
  for (int dt = 0; dt < 8; ++dt) acc_o[dt] = (f32x4){0.f, 0.f, 0.f, 0.f};
  float m_run = -INFINITY, l_run = 0.f, R = 0.f;
  const int kr = tid >> 4, kc = (tid & 15) * 8;
  const int vr = tid >> 3, vc = (tid & 7) * 8;
  u32x4 rk[2][2], rv[2][2]; float rc = 0.f, rcn = 0.f;
#define AT_LOAD(tp) do {   \
    _Pragma("unroll") for (int sb = 0; sb < 2; ++sb) { const int k0_ = (2 * (tp) + 1 - sb) * 64; \
      _Pragma("unroll") for (int i = 0; i < 2; ++i) { rk[sb][i] = *(const u32x4*)(P.K + (size_t)(tb + k0_ + kr + 32 * i) * ld + h * 128 + kc); \
        rv[sb][i] = *(const u32x4*)(P.VT + (size_t)(h * 128 + vr + 64 * i) * T + tb + k0_ + vc); } } \
    if (!SBK) { if (tid < 128) rc = P.CF[bh * SEQ + (2 * (tp) + 1 - (tid >> 6)) * 64 + (tid & 63)]; rcn = P.CF[bh * SEQ + (2 * (tp) + 1) * 64 + 63]; } } while (0)
#define AT_STORE(buf) do { \
    _Pragma("unroll") for (int sb = 0; sb < 2; ++sb) \
      _Pragma("unroll") for (int i = 0; i < 2; ++i) { \
        *(u32x4*)(K_s + ((buf) * 2 + sb) * 8704 + (kr + 32 * i) * 136 + kc) = rk[sb][i]; \
        *(u32x4*)(V_s + ((buf) * 2 + sb) * 9216 + (vr + 64 * i) * 72 + vc) = rv[sb][i]; } \
    if (!SBK && tid < 128) ck_s[((buf) * 2 + (tid >> 6)) * 64 + (tid & 63)] = rc; } while (0)
  const int np2 = qb + 1;
  AT_LOAD(np2 - 1);
  bf16x8 qf[4];
  float zmax = 0.f;
  {
    const bf16_t* qp = P.Q + (size_t)(tb + q) * ld + h * 128 + fq * 8;
    float v[32]; float ss = 0.f;
#pragma unroll
    for (int kk = 0; kk < 4; ++kk) {
      const u32x4 x = *(const u32x4*)(qp + 32 * kk);
      v[kk * 8 + 0] = bflo(x.x); v[kk * 8 + 1] = bfhi(x.x); v[kk * 8 + 2] = bflo(x.y); v[kk * 8 + 3] = bfhi(x.y);
      v[kk * 8 + 4] = bflo(x.z); v[kk * 8 + 5] = bfhi(x.z); v[kk * 8 + 6] = bflo(x.w); v[kk * 8 + 7] = bfhi(x.w);
    }
    float sc = QSCALE;
    float gqm = 0.f, gkm = 0.f;
    if (!SBK) {
#pragma unroll
      for (int e = 0; e < 32; ++e) ss += v[e] * v[e];
      ss += __shfl_xor(ss, 16); ss += __shfl_xor(ss, 32);
      sc = QSCALE * rsqrtf(ss * (1.f / 128.f) + EPS);
    }
#pragma unroll
    for (int kk = 0; kk < 4; ++kk) {
      float g[8];
#pragma unroll
      for (int e = 0; e < 8; ++e) { g[e] = SBK ? 1.f : P.qg[fq * 8 + 32 * kk + e]; if (!SBK) { gqm = fmaxf(gqm, fabsf(g[e])); gkm = fmaxf(gkm, fabsf(P.kg[fq * 8 + 32 * kk + e])); } }
      u32x4 w;
      w.x = pk2(v[kk * 8 + 0] * sc * g[0], v[kk * 8 + 1] * sc * g[1]); w.y = pk2(v[kk * 8 + 2] * sc * g[2], v[kk * 8 + 3] * sc * g[3]);
      w.z = pk2(v[kk * 8 + 4] * sc * g[4], v[kk * 8 + 5] * sc * g[5]); w.w = pk2(v[kk * 8 + 6] * sc * g[6], v[kk * 8 + 7] * sc * g[7]);
      qf[kk] = __builtin_bit_cast(bf16x8, w);
    }
    if (!SBK) {
      gqm = fmaxf(gqm, __shfl_xor(gqm, 16)); gqm = fmaxf(gqm, __shfl_xor(gqm, 32));
      gkm = fmaxf(gkm, __shfl_xor(gkm, 16)); gkm = fmaxf(gkm, __shfl_xor(gkm, 32));
      zmax = 11.3137085f * gqm * gkm * 1.02f + 0.5f;
    }
  }
  AT_STORE(0);
  __syncthreads();
  bool wave_done = false;
  for (int it = 0; it < np2; ++it) {
    const int buf = it & 1;
    if (it > 0) {
      const volatile int* f = dflag + ((it - 1) & 1) * 8;
      if (f[0] & f[1] & f[2] & f[3] & f[4] & f[5] & f[6] & f[7]) break;
    }
    if (it + 1 < np2) AT_LOAD(np2 - 2 - it);
#pragma unroll
    for (int sb = 0; sb < 2; ++sb) {
    const int ti = 2 * (np2 - 1 - it) + 1 - sb; const int k0 = ti * 64; const bool last_tile = (ti == 0);
    if (k0 <= qmax_w && !wave_done) {
      const bf16_t* Kb = K_s + (buf * 2 + sb) * 8704; const bf16_t* Vb = V_s + (buf * 2 + sb) * 9216;
      f32x4 s[4];
#pragma unroll
      for (int kt = 0; kt < 4; ++kt) {
        s[kt] = (f32x4){0.f, 0.f, 0.f, 0.f};
#pragma unroll
        for (int kk = 0; kk < 4; ++kk) s[kt] = MFMA16(*(const bf16x8*)(Kb + (kt * 16 + fr) * 136 + fq * 8 + 32 * kk), qf[kk], s[kt]);
      }
      bf16x8 pf[2];
      if (!SBK) {
        float mx = -INFINITY;
        const bool need_mask = (k0 + 63 > qmin_w);
#pragma unroll
        for (int kt = 0; kt < 4; ++kt) {
          const float4 cv = *(const float4*)(ck_s + (buf * 2 + sb) * 64 + kt * 16 + fq * 4);
          const float cc[4] = {cv.x, cv.y, cv.z, cv.w};
#pragma unroll
          for (int j = 0; j < 4; ++j) { float v = s[kt][j] - cc[j]; if (need_mask) { const int key = k0 + kt * 16 + fq * 4 + j; v = (key <= q) ? v : -INFINITY; } s[kt][j] = v; mx = fmaxf(mx, v); }
        }
        mx = fmaxf(mx, __shfl_xor(mx, 16)); mx = fmaxf(mx, __shfl_xor(mx, 32));
        if (__any(mx > m_run)) {
          const float m_new = fmaxf(m_run, mx);
          const float alpha = __expf(m_run - m_new);
          m_run = m_new;
          l_run *= alpha;
#pragma unroll
          for (int dt = 0; dt < 8; ++dt) acc_o[dt] = acc_o[dt] * alpha;
        }
        float ps = 0.f;
#pragma unroll
        for (int kt = 0; kt < 4; ++kt)
#pragma unroll
          for (int j = 0; j < 4; ++j) { const float p = __expf(s[kt][j] - m_run); s[kt][j] = p; ps += p; }
        l_run += ps;
        if (!last_tile) { const float cnext = (sb == 0) ? ck_s[(buf * 2 + 1) * 64 + 63] : rcn; wave_done = __all(zmax - cnext - m_run < -110.f) != 0; }
      } else {
        float lsig[4][4];
        bf16x8 lf[2];
#pragma unroll
        for (int kt = 0; kt < 4; ++kt)
#pragma unroll
          for (int j = 0; j < 4; ++j) {
            const int key = k0 + kt * 16 + fq * 4 + j; const float z = s[kt][j]; const float sp = softplus_(z);
            lsig[kt][j] = z - sp; s[kt][j] = (key < q) ? -sp : 0.f;
          }
#pragma unroll
        for (int g = 0; g < 2; ++g) { u32x4 w; w.x = pk2(s[2 * g][0], s[2 * g][1]); w.y = pk2(s[2 * g][2], s[2 * g][3]); w.z = pk2(s[2 * g + 1][0], s[2 * g + 1][1]); w.w = pk2(s[2 * g + 1][2], s[2 * g + 1][3]); lf[g] = __builtin_bit_cast(bf16x8, w); }
        f32x4 tl[4], tot;
        const f32x4 zero4 = {0.f, 0.f, 0.f, 0.f};
        tl[0] = MFMA16(Ue, lf[0], zero4); tl[0] = MFMA16(U1, lf[1], tl[0]);
        tl[1] = MFMA16(Uo, lf[0], zero4); tl[1] = MFMA16(U1, lf[1], tl[1]);
        tl[2] = MFMA16(Ue, lf[1], zero4);
        tl[3] = MFMA16(Uo, lf[1], zero4);
        tot = MFMA16(U1, lf[0], zero4); tot = MFMA16(U1, lf[1], tot);
#pragma unroll
        for (int kt = 0; kt < 4; ++kt)
#pragma unroll
          for (int j = 0; j < 4; ++j) { const int key = k0 + kt * 16 + fq * 4 + j; s[kt][j] = (key < q) ? __expf(lsig[kt][j] + tl[kt][j] + R) : 0.f; }
        R += tot[0];
        wave_done = __all(R < -110.f) != 0;
      }
#pragma unroll
      for (int g = 0; g < 2; ++g) { u32x4 w; w.x = pk2(s[2 * g][0], s[2 * g][1]); w.y = pk2(s[2 * g][2], s[2 * g][3]); w.z = pk2(s[2 * g + 1][0], s[2 * g + 1][1]); w.w = pk2(s[2 * g + 1][2], s[2 * g + 1][3]); pf[g] = __builtin_bit_cast(bf16x8, w); }
#pragma unroll
      for (int dt = 0; dt < 8; ++dt)
#pragma unroll
        for (int g = 0; g < 2; ++g) {
          const bf16_t* vp = Vb + (dt * 16 + fr) * 72 + 32 * g + fq * 4;
          u32x4 a; const u32x2 a0 = *(const u32x2*)vp, a1 = *(const u32x2*)(vp + 16);
          a.x = a0.x; a.y = a0.y; a.z = a1.x; a.w = a1.y;
          acc_o[dt] = MFMA16(__builtin_bit_cast(bf16x8, a), pf[g], acc_o[dt]);
        }
    }
    }
    if (it + 1 < np2) AT_STORE(buf ^ 1);
    if (lane == 0) dflag[(it & 1) * 8 + wave] = wave_done ? 1 : 0;
    __syncthreads();
  }
#undef AT_LOAD
#undef AT_STORE
  {
    float inv = 1.f;
    if (!SBK) { float l = l_run; l += __shfl_xor(l, 16); l += __shfl_xor(l, 32); inv = 1.f / l; }
    bf16_t* op = P.O + (size_t)(tb + q) * 1024 + h * 128 + fq * 4;
#pragma unroll
    for (int dt = 0; dt < 8; ++dt) {
      float o0 = acc_o[dt][0] * inv, o1 = acc_o[dt][1] * inv, o2 = acc_o[dt][2] * inv, o3 = acc_o[dt][3] * inv;
      if (!SBK) {
        const u32x2 gv = *(const u32x2*)(P.gate + (size_t)(tb + q) * ld + h * 128 + dt * 16 + fq * 4);
        o0 *= sigmoid_(bflo(gv.x)); o1 *= sigmoid_(bfhi(gv.x)); o2 *= sigmoid_(bflo(gv.y)); o3 *= sigmoid_(bfhi(gv.y));
      }
      u32x2 p; p.x = pk2(o0, o1); p.y = pk2(o2, o3);
      *(u32x2*)(op + dt * 16) = p;
    }
  }
}

__device__ __forceinline__ void fox_knorm(bf16_t* Kb  , const float* kg) {
  const int tid = tid_fresh();
  const int seg = tid & 15;
  float g[8];
#pragma unroll
  for (int e = 0; e < 8; ++e) g[e] = kg[seg * 8 + e];
  for (int it = blockIdx.x * 32 + (tid >> 4); it < T * 4; it += gridDim.x * 32) {
    const int t = it >> 2, h = it & 3;
    bf16_t* p = Kb + (size_t)t * 3584 + h * 128 + seg * 8;
    u32x4 x = *(const u32x4*)p;
    float v[8]; v[0] = bflo(x.x); v[1] = bfhi(x.x); v[2] = bflo(x.y); v[3] = bfhi(x.y); v[4] = bflo(x.z); v[5] = bfhi(x.z); v[6] = bflo(x.w); v[7] = bfhi(x.w);
    float ss = 0.f;
#pragma unroll
    for (int e = 0; e < 8; ++e) ss += v[e] * v[e];
    ss += __shfl_xor(ss, 1); ss += __shfl_xor(ss, 2); ss += __shfl_xor(ss, 4); ss += __shfl_xor(ss, 8);
    const float r = rsqrtf(ss * (1.f / 128.f) + EPS);
    x.x = pk2(v[0] * r * g[0], v[1] * r * g[1]); x.y = pk2(v[2] * r * g[2], v[3] * r * g[3]); x.z = pk2(v[4] * r * g[4], v[5] * r * g[5]); x.w = pk2(v[6] * r * g[6], v[7] * r * g[7]);
    *(u32x4*)p = x;
  }
}

#ifndef NREP_G
#define NREP_G 1
#endif
#ifndef REP_MODE
#define REP_MODE -1
#endif
#ifndef NREP_N
#define NREP_N 1
#endif
#ifndef NREP_P
#define NREP_P 1
#endif
#ifndef NREP_S
#define NREP_S 1
#endif
#ifndef NREP_F
#define NREP_F 1
#endif
#ifndef NREP_B
#define NREP_B 1
#endif


#define WSP(T_, off) ((T_*)(ws + (off)))
#define GRID_BAR() do { XcdBarrier b_; b_.bar = (unsigned*)(fresh_args()->ws + WS_BAR); b_.x = xb_xcc_id(); b_.st = (volatile LAS unsigned*)(glds + 151 * 1024); xcd_barrier(b_); } while (0)

#ifdef DEBUG_NAN
__device__ __forceinline__ void chk_words(const unsigned* p, size_t nwords, bool bf, unsigned* err, unsigned code) {
  bool bad = false, nan = false;
  for (size_t i = ((size_t)blockIdx.x * 512 + threadIdx.x); i < nwords; i += (size_t)gridDim.x * 512) {
    const unsigned w = p[i];
    if ((w & 0x7F800000u) >= (141u << 23)) bad = true;
    if ((w & 0x7F800000u) == 0x7F800000u) nan = true;
    if (bf && (w & 0x7F80u) >= (141u << 7)) bad = true;
    if (bf && (w & 0x7F80u) == 0x7F80u) nan = true;
  }
  if (bad) atomicCAS(err, 0u, code);
  if (nan) atomicCAS(err + 1, 0u, code);
}
#endif

__global__ void __launch_bounds__(512, 2) fwd_megakernel(Args a_unused) {
  extern __shared__ __attribute__((aligned(16))) unsigned char lds[];
  cg::grid_group grid = cg::this_grid();
  PG8_LAS unsigned char* glds = (PG8_LAS unsigned char*)lds;
  const int G = gridDim.x, bid = blockIdx.x;
  asm volatile("s_nop 0");
  asm volatile("s_nop 0");
  if (threadIdx.x < 4) ((volatile LAS unsigned*)(glds + 151 * 1024))[threadIdx.x] = 0u;
  __syncthreads();
  (void)xcd_barrier_post((unsigned*)(fresh_args()->ws + WS_BAR), (volatile LAS unsigned*)(glds + 151 * 1024));
  if (gridDim.x == 0x7fffffffu) grid.sync();

  for (int step = 0; step < 8; ++step) {
    const int l = step >> 1, which = step & 1, j = l >> 1; const bool even = (l & 1) == 0;
    const int np = which ? 3 : 10;
    const int nmain = even ? 3584 : 2048, nv = even ? 512 : 1024;
    for (int p = 0; p < np; ++p) {
      if ((p == 6 || p == 8) && !even) continue;
      if (p == 3 || (p == 0 && which == 1)) continue;
      if (p == 1 || p == 2 || p == 4 || p == 5 || p == 9) {
        ArgsP a = fresh_args(); unsigned char* ws = a->ws;
        const bf16_t* gA; const bf16_t* gB; int gM, gN, gK, emode, eldc; void* eP; float escale; int oid = bid;
        if (p == 1) { gA = WSP(bf16_t, WS_XN); gB = which ? WSP(bf16_t, WS_GU2) : WSP(bf16_t, WS_GU1); gM = T; gN = 5632; gK = 1024; emode = 0; eP = WSP(void, WS_BIG); eldc = FF; escale = 0.f; }
        else if (p == 2) { gA = WSP(bf16_t, WS_BIG); gB = which ? WSP(bf16_t, WS_DN2) : WSP(bf16_t, WS_DN1); gM = T; gN = 1024; gK = FF; emode = 1; eP = a->out; eldc = 1024; escale = 0.5f; }
        else if (p == 4) { gA = WSP(bf16_t, WS_XN); gB = WSP(bf16_t, WS_WIN); gM = T; gN = nmain; gK = 1024; emode = 2; eP = WSP(void, WS_BIG); eldc = nmain; escale = 0.f;
                           if (even) norm_phase<true>(lds, a->out, nullptr, a->in[4] + l * 1024, nullptr, a->in[5] + (size_t)j * 1024 * 4108, a->in[7] + j * 4, a->in[8] + j * 4, a->in[12] + j * 4, WSP(float, WS_SM)); }
        else if (p == 5) { gA = WSP(bf16_t, WS_WIN) + (size_t)nmain * 1024; gB = WSP(bf16_t, WS_XN); gM = nv; gN = T; gK = 1024; emode = 3; eP = WSP(void, WS_VT); eldc = T; escale = 0.f; if (even) oid = (bid + G / 2) % G; }
        else { gA = WSP(bf16_t, WS_OB); gB = WSP(bf16_t, WS_WOUT); gM = T; gN = 1024; gK = 1024; emode = 1; eP = a->out; eldc = 1024; escale = 1.0f; }
        const pg8::Gemm g{gA, gB, gM, gN, gK};
        const EpiAny E{emode, eP, eldc, escale};
        pg8::StaticOrder S; S.init(g.M, g.N, G, oid);
#ifndef NO_G
#if NREP_G > 1
        for (int rep = 0; rep < ((REP_MODE < 0 || emode == REP_MODE) ? NREP_G : 1); ++rep) { EpiAny Er = E; if (rep + 1 < ((REP_MODE < 0 || emode == REP_MODE) ? NREP_G : 1)) Er.scale = 0.f; pg8::gemm_phase<EpiAny, pg8::StaticOrder>(glds, g, S, Er, nullptr); }
#else
        pg8::gemm_phase<EpiAny, pg8::StaticOrder>(glds, g, S, E, nullptr);
#endif
#endif
        if (p == 4) continue;
      } else if (p == 0) {
        for (int rep = 0; rep < NREP_N; ++rep) {
        ArgsP a = fresh_args(); unsigned char* ws = a->ws;
        convert_layer((float*)lds, even, l, j, a, ws);
        if (step == 0) init_phase(a->in[0], a->out, WSP(bf16_t, WS_XN), WSP(float, WS_PS));
        }
      } else if (p == 6) {
#ifndef NO_PREP
        ArgsP a = fresh_args(); unsigned char* ws = a->ws;
        cumsum_logf(lds, WSP(float, WS_SM), WSP(float, WS_CF));
        fox_knorm(WSP(bf16_t, WS_BIG) + 2560, a->in[11] + j * 128);
        for (int rep = 0; rep < NREP_P; ++rep) for (int u = bid; u < 1024; u += G) dn_prep_unit(lds, u, WSP(bf16_t, WS_BIG), WSP(float, WS_SM), a->in[6] + (size_t)j * 4 * 1536, ws + WS_DNX, WSP(float, WS_GL));
#endif
      } else if (p == 8) {
        ArgsP a = fresh_args(); unsigned char* ws = a->ws;
        dn_fixup(WSP(float, WS_OF), WSP(float, WS_PSD), WSP(bf16_t, WS_BIG), a->in[9] + j * 128, WSP(bf16_t, WS_OB));
      } else if (p == 7) {
        if (even) {
#ifndef NO_SCAN
          if (bid < 64) for (int rep = 0; rep < NREP_S; ++rep) { ArgsP a = fresh_args(); unsigned char* ws = a->ws; dn_scan(lds, bid, ws + WS_DNX, WSP(float, WS_GL), WSP(float, WS_OF), WSP(float, WS_PSD)); }
#endif
          ArgsP a = fresh_args(); unsigned char* ws = a->ws;
          int* qslot = (int*)(lds + 150 * 1024);
          AttnP P; P.Q = WSP(bf16_t, WS_BIG) + 2048; P.K = WSP(bf16_t, WS_BIG) + 2560; P.ld = 3584; P.VT = WSP(bf16_t, WS_VT); P.qg = a->in[10] + j * 128; P.kg = a->in[11] + j * 128;
          P.CF = WSP(float, WS_CF); P.gate = WSP(bf16_t, WS_BIG) + 3072; P.O = WSP(bf16_t, WS_OB) + 512; P.H = 4;
          for (int rep = 0; rep < NREP_F; ++rep) {
          unsigned* ctr = WSP(unsigned, WS_CTL) + l + 8 * rep;
          for (;;) {
            if (threadIdx.x == 0) *qslot = (int)atomicAdd(ctr, 1u);
            __syncthreads();
            const int unit = *qslot;
            __syncthreads();
            if (unit >= 512) break;
#ifndef NO_FOX
            attn_unit<false>(lds, P, unit & 15, 31 - (unit >> 4));
#endif
          }
          }
        } else {
          ArgsP a = fresh_args(); unsigned char* ws = a->ws;
          int* qslot = (int*)(lds + 150 * 1024);
          AttnP P; P.Q = WSP(bf16_t, WS_BIG); P.K = WSP(bf16_t, WS_BIG) + 1024; P.ld = 2048; P.VT = WSP(bf16_t, WS_VT); P.qg = nullptr; P.kg = nullptr; P.CF = nullptr; P.gate = nullptr; P.O = WSP(bf16_t, WS_OB); P.H = 8;
          for (int rep = 0; rep < NREP_B; ++rep) {
          unsigned* ctr = WSP(unsigned, WS_CTL) + l + 8 * rep;
          for (;;) {
            if (threadIdx.x == 0) *qslot = (int)atomicAdd(ctr, 1u);
            __syncthreads();
            const int unit = *qslot;
            __syncthreads();
            if (unit >= 1024) break;
#ifndef NO_SB
            attn_unit<true>(lds, P, unit & 31, 31 - (unit >> 5));
#endif
          }
          }
        }
      }
      GRID_BAR();
#ifdef NREP_Y
      GRID_BAR();
#endif
#ifdef DEBUG_NAN
      {
        ArgsP a = fresh_args(); unsigned* err = (unsigned*)(a->ws + WS_CTL) + 64; const unsigned code = (unsigned)(step * 10 + p + 1);
        const unsigned* cp = nullptr; size_t nw = 0; bool bf = true;
        if (p == 0 || p == 3) { cp = (const unsigned*)(a->ws + WS_XN); nw = (size_t)T * 512; }
        if (p == 1) { cp = (const unsigned*)(a->ws + WS_BIG); nw = (size_t)T * FF / 2; }
        if (p == 2 || p == 8) { cp = (const unsigned*)a->out; nw = (size_t)T * 1024; bf = false; }
        if (p == 5) { cp = (const unsigned*)(a->ws + WS_BIG); nw = (size_t)T * nmain / 2; }
        if (p == 6) { cp = (const unsigned*)(a->ws + WS_DNX); nw = (size_t)1024 * DNX_UNIT / 4; }
        if (p == 7) { cp = (const unsigned*)(a->ws + WS_OB); nw = (size_t)T * 512; }
        chk_words(cp, nw, bf, err, code);
        if (p == 5) chk_words((const unsigned*)(a->ws + WS_VT), (size_t)T * nv / 2, true, err, 90u + (unsigned)step);
      }
#endif
    }
  }
#ifdef DEBUG_NAN
  {
    ArgsP a = fresh_args(); float* X = a->out; const unsigned err = *((volatile unsigned*)(a->ws + WS_CTL) + 64), errn = *((volatile unsigned*)(a->ws + WS_CTL) + 65);
    for (size_t i = ((size_t)blockIdx.x * 512 + threadIdx.x); i < (size_t)T * 1024; i += (size_t)gridDim.x * 512) {
      X[i] = (i == 5 && (err | errn)) ? (errn ? 100.f * (float)errn : (float)err) : 0.f;
    }
  }
#endif
}

extern "C" void kernel_launch(void* const* d_in, const int* in_sizes, int n_in,
                              void* d_out, int out_size, void* d_ws, size_t ws_size,
                              hipStream_t stream) {
  static int grid = 0;
  if (grid == 0) {
    int dev = 0, cus = 0, per_cu = 0;
    (void)hipGetDevice(&dev);
    (void)hipDeviceGetAttribute(&cus, hipDeviceAttributeMultiprocessorCount, dev);
    (void)hipFuncSetAttribute((const void*)fwd_megakernel, hipFuncAttributeMaxDynamicSharedMemorySize, LDS_BYTES);
    (void)hipOccupancyMaxActiveBlocksPerMultiprocessor(&per_cu, (const void*)fwd_megakernel, 512, LDS_BYTES);
    (void)hipGetLastError();
    grid = cus > 0 ? cus : 256;
    if (ws_size < WS_END || n_in != 19) { fprintf(stderr, "kernel_launch: ws %zu < %zu or n_in %d\n", ws_size, (size_t)WS_END, n_in); grid = -1; }
    fprintf(stderr, "kernel_launch: cus %d per_cu %d grid %d ws %zu need %zu\n", cus, per_cu, grid, ws_size, (size_t)WS_END);
  }
  if (grid < 0) return;
  (void)hipMemsetAsync((char*)d_ws + WS_CTL, 0, CTL_BYTES, stream);
  Args a{};
  for (int i = 0; i < 19; ++i) a.in[i] = (const float*)d_in[i];
  a.out = (float*)d_out; a.ws = (unsigned char*)d_ws;
  void* args[] = {&a};
  hipError_t e = hipLaunchCooperativeKernel((const void*)fwd_megakernel, dim3(grid), dim3(512), args, LDS_BYTES, stream);
  if (e != hipSuccess) fprintf(stderr, "cooperative launch failed: %s (grid %d)\n", hipGetErrorString(e), grid);
}
```
